# Optimizing an MI355X kernel written in HIP

```python
import math
import jax, jax.numpy as jnp
from jax import lax
import numpy as np

D_MODEL = 2048
BATCH = 1
SEQ = 16384
DEPTH = 2

N_BRANCH = 4
BRANCH_W = D_MODEL // N_BRANCH
NSA_HEADS = 8
NSA_KV_GROUPS = 2
NSA_HEAD_DIM = BRANCH_W // NSA_HEADS
CMP_LEN = 32
CMP_STRIDE = 16
SLC_BLOCK = 64
SLC_TOP_N = 16
WIN = 512
Q_BLOCK = 128
S5_GROUP = 16
S5_GROUPS = BRANCH_W // S5_GROUP
S5_STATE = 64
POOL_WINDOWS = (2, 4, 8, 16)
POOL_GROUPS = len(POOL_WINDOWS)
POOL_GROUP = BRANCH_W // POOL_GROUPS
RET_HEADS = 4
RET_HEAD_DIM = BRANCH_W // RET_HEADS
RET_CHUNK = 128
D_FF = 4 * D_MODEL
PLE_DIM = 256
NORM_EPS = 1e-6
NEG_INF = -1e30
FORCE_BONUS = 1e4

NSA_Q_COLS = NSA_HEADS * NSA_HEAD_DIM
NSA_KV_COLS = 6 * NSA_KV_GROUPS * NSA_HEAD_DIM
NSA_GATE_COLS = 3 * NSA_HEADS
SPLIT_SIZES = (NSA_Q_COLS, NSA_KV_COLS, NSA_GATE_COLS, BRANCH_W, BRANCH_W,
               BRANCH_W, BRANCH_W, BRANCH_W, BRANCH_W, N_BRANCH * D_MODEL)
IN_COLS = sum(SPLIT_SIZES)

kernel_name = "hybrid_nsa_s5_pool_retention_block"


def rms_norm(x, g):
    x32 = x.astype(jnp.float32)
    y = x32 * lax.rsqrt(jnp.mean(x32 * x32, axis=-1, keepdims=True) + NORM_EPS)
    return (y * g.astype(jnp.float32)).astype(x.dtype)


def masked_softmax(s, mask, axis):
    s = jnp.where(mask, s, NEG_INF)
    e = jnp.exp(s - jnp.max(s, axis=axis, keepdims=True)) * mask
    return e / jnp.maximum(jnp.sum(e, axis=axis, keepdims=True), 1e-30)


def nsa_mixer(q, kv, gates, w_cmp_k, w_cmp_v):
    B, S, _ = q.shape
    H, G, dh = NSA_HEADS, NSA_KV_GROUPS, NSA_HEAD_DIM
    R = H // G
    f32 = jnp.float32
    q = q.reshape(B, S, G, R, dh)
    kv6 = kv.reshape(B, S, 6, G, dh)
    k_cmp, v_cmp, k_slc, v_slc, k_win, v_win = [kv6[:, :, i] for i in range(6)]
    gates = jax.nn.sigmoid(gates.astype(f32)).reshape(B, S, 3, G, R)
    scale = dh ** -0.5

    n_cmp = (S - CMP_LEN) // CMP_STRIDE + 1
    blk_idx = jnp.arange(n_cmp)[:, None] * CMP_STRIDE + jnp.arange(CMP_LEN)[None, :]
    kc = jnp.einsum('bnlgd,lde->bnge', k_cmp[:, blk_idx], w_cmp_k)
    vc = jnp.einsum('bnlgd,lde->bnge', v_cmp[:, blk_idx], w_cmp_v)
    cmp_end = blk_idx[:, -1]

    n_slc = S // SLC_BLOCK
    top_n = min(SLC_TOP_N, n_slc)
    slc_start = jnp.arange(n_slc) * SLC_BLOCK
    overlap = ((blk_idx[:, 0][:, None] < slc_start[None, :] + SLC_BLOCK)
               & (cmp_end[:, None] >= slc_start[None, :])).astype(f32)
    ks_blocks = k_slc.reshape(B, n_slc, SLC_BLOCK, G, dh).transpose(0, 3, 1, 2, 4)
    vs_blocks = v_slc.reshape(B, n_slc, SLC_BLOCK, G, dh).transpose(0, 3, 1, 2, 4)
    b_ix = jnp.arange(B)[:, None, None, None]
    g_ix = jnp.arange(G)[None, :, None, None]

    k_win_p = jnp.pad(k_win, ((0, 0), (WIN, 0), (0, 0), (0, 0)))
    v_win_p = jnp.pad(v_win, ((0, 0), (WIN, 0), (0, 0), (0, 0)))

    def query_block(c):
        start = c * Q_BLOCK
        t = start + jnp.arange(Q_BLOCK)
        qb = lax.dynamic_slice_in_dim(q, start, Q_BLOCK, axis=1)
        gb = lax.dynamic_slice_in_dim(gates, start, Q_BLOCK, axis=1)

        s = jnp.einsum('bqgrd,bngd->bgrqn', qb, kc).astype(f32) * scale
        p_cmp = masked_softmax(s, cmp_end[None, :] <= t[:, None], axis=-1)
        o_cmp = jnp.einsum('bgrqn,bngd->bqgrd', p_cmp.astype(vc.dtype), vc)

        imp = jnp.einsum('bgrqn,nj->bgqj', p_cmp, overlap)
        j = jnp.arange(n_slc)
        forced = (j[None, :] == 0) | (j[None, :] == (t // SLC_BLOCK)[:, None])
        valid = slc_start[None, :] <= t[:, None]
        imp = jnp.where(valid, imp + jnp.where(forced, FORCE_BONUS, 0.0), NEG_INF)
        _, sel = lax.top_k(imp, top_n)
        ks = ks_blocks[b_ix, g_ix, sel]
        vs = vs_blocks[b_ix, g_ix, sel]
        s = jnp.einsum('bqgrd,bgqnld->bgrqnl', qb, ks).astype(f32) * scale
        key_pos = sel[..., None] * SLC_BLOCK + jnp.arange(SLC_BLOCK)
        mask = (key_pos <= t[:, None, None])[:, :, None]
        p_slc = masked_softmax(s, mask, axis=(-2, -1))
        o_slc = jnp.einsum('bgrqnl,bgqnld->bqgrd', p_slc.astype(vs.dtype), vs)

        kw = lax.dynamic_slice_in_dim(k_win_p, start, Q_BLOCK + WIN, axis=1)
        vw = lax.dynamic_slice_in_dim(v_win_p, start, Q_BLOCK + WIN, axis=1)
        pos = start - WIN + jnp.arange(Q_BLOCK + WIN)
        mask = ((pos[None, :] <= t[:, None]) & (pos[None, :] > t[:, None] - WIN)
                & (pos[None, :] >= 0))
        s = jnp.einsum('bqgrd,bkgd->bgrqk', qb, kw).astype(f32) * scale
        p_win = masked_softmax(s, mask, axis=-1)
        o_win = jnp.einsum('bgrqk,bkgd->bqgrd', p_win.astype(vw.dtype), vw)

        o = (gb[:, :, 0, :, :, None] * o_cmp + gb[:, :, 1, :, :, None] * o_slc
             + gb[:, :, 2, :, :, None] * o_win)
        return o.astype(q.dtype)

    out = lax.map(query_block, jnp.arange(S // Q_BLOCK))
    return out.transpose(1, 0, 2, 3, 4, 5).reshape(B, S, H * dh)


def _linear_recurrence(l, r):
    a_l, b_l = l
    a_r, b_r = r
    return a_l * a_r, a_r * b_l + b_r


def s5_mixer(u, a_re, a_im, log_dt, b_re, b_im, c_re, c_im, d_skip, w_glu):
    B, S, _ = u.shape
    f32 = jnp.float32
    u32 = u.astype(f32).reshape(B, S, S5_GROUPS, S5_GROUP)
    A = lax.complex(a_re.astype(f32), a_im.astype(f32))
    dt = jnp.exp(log_dt.astype(f32))[:, None]
    A_bar = jnp.exp(A * dt)
    Bm = lax.complex(b_re.astype(f32), b_im.astype(f32))
    B_bar = ((A_bar - 1.0) / A)[..., None] * Bm
    Bu = jnp.einsum('gnc,bsgc->bsgn', B_bar, u32.astype(jnp.complex64))
    a = jnp.broadcast_to(A_bar, Bu.shape)
    _, h = lax.associative_scan(_linear_recurrence, (a, Bu), axis=1)
    Cm = lax.complex(c_re.astype(f32), c_im.astype(f32))
    y = jnp.real(jnp.einsum('gcn,bsgn->bsgc', Cm, h))
    y = y + d_skip.astype(f32).reshape(S5_GROUPS, S5_GROUP) * u32
    y = jax.nn.gelu(y).reshape(B, S, BRANCH_W).astype(u.dtype)
    ga, gb = jnp.split(y @ w_glu, 2, axis=-1)
    return ga * jax.nn.sigmoid(gb)


def pool_mixer(u, w_pool, pool_scale):
    B, S, _ = u.shape
    f32 = jnp.float32
    u32 = u.astype(f32).reshape(B, S, POOL_GROUPS, POOL_GROUP)
    csum = jnp.concatenate([jnp.zeros((B, 1, POOL_GROUPS, POOL_GROUP), f32),
                            jnp.cumsum(u32, axis=1)], axis=1)
    t = jnp.arange(S)
    pooled = []
    for gi, w in enumerate(POOL_WINDOWS):
        cg = csum[:, :, gi]
        lower = jnp.concatenate([jnp.zeros((B, w - 1, POOL_GROUP), f32), cg[:, :S - w + 1]], axis=1)
        count = jnp.minimum(t + 1, w).astype(f32)[:, None]
        pooled.append((cg[:, 1:] - lower) / count)
    pooled = jnp.stack(pooled, axis=2)
    y = jnp.einsum('bsgc,gcd->bsgd', (pooled - u32).astype(u.dtype), w_pool)
    return y.reshape(B, S, BRANCH_W) * pool_scale


def _rotate_every_two(x):
    x1 = x[..., ::2]
    x2 = x[..., 1::2]
    return jnp.stack((-x2, x1), axis=-1).reshape(x.shape)


def retention_mixer(q, k, v, gate):
    B, S, _ = q.shape
    H, dh, C = RET_HEADS, RET_HEAD_DIM, RET_CHUNK
    f32 = jnp.float32
    q = q.astype(f32).reshape(B, S, H, dh)
    k = k.astype(f32).reshape(B, S, H, dh)
    v = v.astype(f32).reshape(B, S, H, dh)
    angle = jnp.repeat(1.0 / (10000.0 ** jnp.linspace(0.0, 1.0, dh // 2)), 2)
    ang = jnp.arange(S, dtype=f32)[:, None] * angle[None, :]
    sin, cos = jnp.sin(ang)[:, None, :], jnp.cos(ang)[:, None, :]
    q = q * cos + _rotate_every_two(q) * sin
    k = (k * cos + _rotate_every_two(k) * sin) * dh ** -0.5
    n_ch = S // C

    def chunks(x):
        return x.reshape(B, n_ch, C, H, dh).transpose(1, 0, 3, 2, 4)

    log_g = jnp.log(1.0 - 2.0 ** (-5.0 - jnp.arange(H, dtype=f32)))
    idx = jnp.arange(C, dtype=f32)
    rel = idx[:, None] - idx[None, :]
    decay = jnp.where(rel >= 0, jnp.exp(jnp.maximum(rel, 0.0)[None] * log_g[:, None, None]), 0.0)
    xi = jnp.exp((idx + 1.0)[None, :] * log_g[:, None])[..., None]
    zeta = jnp.exp((C - 1.0 - idx)[None, :] * log_g[:, None])[..., None]
    g_chunk = jnp.exp(C * log_g)[:, None, None]

    def step(state, inp):
        qc, kc, vc = inp
        inner = jnp.einsum('bhnm,bhme->bhne', jnp.einsum('bhnd,bhmd->bhnm', qc, kc) * decay, vc)
        cross = jnp.einsum('bhnd,bhde->bhne', qc, state) * xi
        state = state * g_chunk + jnp.einsum('bhmd,bhme->bhde', kc * zeta, vc)
        return state, inner + cross

    state0 = jnp.zeros((B, H, dh, dh), f32)
    _, y = lax.scan(step, state0, (chunks(q), chunks(k), chunks(v)))
    y = y.transpose(1, 0, 3, 2, 4).reshape(B, S, H, dh)
    y = y * lax.rsqrt(jnp.mean(y * y, axis=-1, keepdims=True) + NORM_EPS)
    return (jax.nn.silu(gate.astype(f32)) * y.reshape(B, S, H * dh)).astype(gate.dtype)


def setup_inputs(seed: int = 0) -> dict:
    key = jax.random.key(seed)
    ks = jax.random.split(key, 32)
    f32 = jnp.float32
    L = DEPTH

    def nrm(k, shape, scale):
        return jax.random.normal(k, shape, f32) * scale

    return {
        "x": nrm(ks[0], (BATCH, SEQ, D_MODEL), 1.0),
        "p": nrm(ks[1], (DEPTH, BATCH, SEQ, PLE_DIM), 1.0),
        "g_mix": 1.0 + nrm(ks[2], (L, D_MODEL), 0.1),
        "w_in": nrm(ks[3], (L, D_MODEL, IN_COLS), D_MODEL ** -0.5),
        "w_cmp_k": nrm(ks[4], (L, CMP_LEN, NSA_HEAD_DIM, NSA_HEAD_DIM), (CMP_LEN * NSA_HEAD_DIM) ** -0.5),
        "w_cmp_v": nrm(ks[5], (L, CMP_LEN, NSA_HEAD_DIM, NSA_HEAD_DIM), (CMP_LEN * NSA_HEAD_DIM) ** -0.5),
        "s5_a_re": -0.5 + nrm(ks[6], (L, S5_GROUPS, S5_STATE), 0.01),
        "s5_a_im": math.pi * jnp.arange(S5_STATE, dtype=f32)[None, None, :] + nrm(ks[7], (L, S5_GROUPS, S5_STATE), 0.01),
        "s5_log_dt": jax.random.uniform(ks[8], (L, S5_GROUPS), f32, math.log(1e-3), math.log(1e-1)),
        "s5_b_re": nrm(ks[9], (L, S5_GROUPS, S5_STATE, S5_GROUP), (2 * S5_GROUP) ** -0.5),
        "s5_b_im": nrm(ks[10], (L, S5_GROUPS, S5_STATE, S5_GROUP), (2 * S5_GROUP) ** -0.5),
        "s5_c_re": nrm(ks[11], (L, S5_GROUPS, S5_GROUP, S5_STATE), (2 * S5_STATE) ** -0.5),
        "s5_c_im": nrm(ks[12], (L, S5_GROUPS, S5_GROUP, S5_STATE), (2 * S5_STATE) ** -0.5),
        "s5_d": nrm(ks[13], (L, BRANCH_W), 1.0),
        "s5_w_glu": nrm(ks[14], (L, BRANCH_W, 2 * BRANCH_W), BRANCH_W ** -0.5),
        "pool_w": nrm(ks[15], (L, POOL_GROUPS, POOL_GROUP, POOL_GROUP), POOL_GROUP ** -0.5),
        "pool_scale": 1.0 + nrm(ks[16], (L, BRANCH_W), 0.1),
        "w_branch": nrm(ks[17], (L, N_BRANCH, BRANCH_W, D_MODEL), BRANCH_W ** -0.5),
        "w_out": nrm(ks[18], (L, D_MODEL, D_MODEL), D_MODEL ** -0.5),
        "g_mlp": 1.0 + nrm(ks[19], (L, D_MODEL), 0.1),
        "w_mlp_up": nrm(ks[20], (L, D_MODEL, D_FF), D_MODEL ** -0.5),
        "w_mlp_down": nrm(ks[21], (L, D_FF, D_MODEL), D_FF ** -0.5),
        "w_ple_gate": nrm(ks[22], (L, D_MODEL, D_MODEL), D_MODEL ** -0.5),
        "w_ple_proj": nrm(ks[23], (L, PLE_DIM, D_MODEL), PLE_DIM ** -0.5),
        "g_final": 1.0 + nrm(ks[24], (D_MODEL,), 0.1),
    }


def reference(x, p, g_mix, w_in, w_cmp_k, w_cmp_v, s5_a_re, s5_a_im, s5_log_dt, s5_b_re, s5_b_im,
              s5_c_re, s5_c_im, s5_d, s5_w_glu, pool_w, pool_scale, w_branch, w_out, g_mlp,
              w_mlp_up, w_mlp_down, w_ple_gate, w_ple_proj, g_final):
    B, S, D = x.shape
    offsets = [0]
    for size in SPLIT_SIZES:
        offsets.append(offsets[-1] + size)
    h = x
    for i in range(DEPTH):
        u = rms_norm(h, g_mix[i])
        z = u @ w_in[i]
        (z_nsa_q, z_nsa_kv, z_nsa_g, z_s5, z_pool, z_rq, z_rk, z_rv, z_rg, z_merge) = [
            z[..., offsets[j]:offsets[j + 1]] for j in range(len(SPLIT_SIZES))]

        o_nsa = nsa_mixer(z_nsa_q, z_nsa_kv, z_nsa_g, w_cmp_k[i], w_cmp_v[i])
        o_s5 = s5_mixer(z_s5, s5_a_re[i], s5_a_im[i], s5_log_dt[i], s5_b_re[i], s5_b_im[i],
                        s5_c_re[i], s5_c_im[i], s5_d[i], s5_w_glu[i])
        o_pool = pool_mixer(z_pool, pool_w[i], pool_scale[i])
        o_ret = retention_mixer(z_rq, z_rk, z_rv, z_rg)

        merge_gates = jax.nn.sigmoid(z_merge.reshape(B, S, N_BRANCH, D))
        merged = jnp.zeros_like(h)
        for j, o in enumerate((o_nsa, o_s5, o_pool, o_ret)):
            merged = merged + merge_gates[:, :, j] * (o @ w_branch[i, j])
        h = h + merged @ w_out[i]

        v = rms_norm(h, g_mlp[i])
        h = h + jnp.square(jax.nn.relu(v @ w_mlp_up[i])) @ w_mlp_down[i]

        h = h + jax.nn.sigmoid(h @ w_ple_gate[i]) * (p[i] @ w_ple_proj[i])
    return rms_norm(h, g_final)
```

```cpp
#include <hip/hip_runtime.h>
#include <hip/hip_cooperative_groups.h>
#include <cstdio>
namespace cg = cooperative_groups;

#define DI __device__ __forceinline__
#define LAS __attribute__((address_space(3)))
typedef unsigned short bf16_t;
typedef short bf16x8 __attribute__((ext_vector_type(8)));
typedef short s16x4 __attribute__((ext_vector_type(4)));
typedef float f32x2 __attribute__((ext_vector_type(2)));
typedef float f32x4 __attribute__((ext_vector_type(4)));
typedef float f32x16 __attribute__((ext_vector_type(16)));
typedef unsigned u32x2 __attribute__((ext_vector_type(2)));
typedef unsigned u32x4 __attribute__((ext_vector_type(4)));
typedef __bf16 bf16v2 __attribute__((ext_vector_type(2)));

constexpr int S = 16384, DM = 2048, ZW = 4608, NIN = 12800, DFF = 8192;
constexpr int LDS_BYTES = 143360;

constexpr size_t OFF_WIN = 0;
constexpr size_t OFF_WUP = OFF_WIN + (size_t)NIN * DM * 2;
constexpr size_t OFF_WDN = OFF_WUP + (size_t)DFF * DM * 2;
constexpr size_t OFF_WOUT = OFF_WDN + (size_t)DFF * DM * 2;
constexpr size_t OFF_WPG = OFF_WOUT + (size_t)DM * DM * 2;
constexpr size_t OFF_WBR = OFF_WPG + (size_t)DM * DM * 2;
constexpr size_t OFF_WPP = OFF_WBR + (size_t)8192 * 512 * 2;
constexpr size_t OFF_WGP = OFF_WPP + (size_t)DM * 256 * 2;
constexpr size_t OFF_WCMP = OFF_WGP + (size_t)1536 * 512 * 2;
constexpr size_t OFF_PBF = OFF_WCMP + (size_t)128 * 2048 * 2;
constexpr size_t OFF_TRIG = OFF_PBF + (size_t)S * 256 * 2;
constexpr size_t OFF_S5P = OFF_TRIG + (size_t)S * 64 * 8;
constexpr size_t OFF_S5E = OFF_S5P + 294912;
constexpr size_t OFF_ZM = OFF_S5E + (size_t)32 * 128 * 64 * 8;
constexpr size_t OFF_G8 = OFF_ZM + (size_t)(S + 64) * ZW * 2;
constexpr size_t OFF_XB = OFF_G8 + (size_t)S * 8192;
constexpr size_t OFF_R2 = OFF_XB + (size_t)S * DM * 2;
constexpr size_t OFF_O4 = OFF_R2 + (size_t)S * DM * 2;
constexpr size_t OFF_KC = OFF_O4 + (size_t)4 * S * 512 * 2;
constexpr size_t OFF_VCT = OFF_KC + (size_t)2 * 1024 * 64 * 2;
constexpr size_t OFF_VT = OFF_VCT + (size_t)2 * 64 * 1024 * 2;
constexpr size_t OFF_KVT = OFF_VT + (size_t)4 * 64 * S * 2;
constexpr size_t OFF_STT = OFF_KVT + (size_t)128 * 65536 * 4;
constexpr size_t OFF_BAR = OFF_STT + (size_t)128 * 65536 * 2;
constexpr size_t OFF_SS = OFF_BAR + 16384;
constexpr size_t OFF_PPB = OFF_SS + 3 * 65536;
constexpr size_t WS_END = OFF_PPB + (size_t)S * DM * 2;
constexpr size_t OFF_HID = OFF_ZM;
static_assert((size_t)S * DFF * 2 <= OFF_XB - OFF_ZM, "hidden alias");

constexpr int ZC_Q = 0, ZC_KV = 512, ZC_S5 = 1280, ZC_POOL = 1792, ZC_RQ = 2304, ZC_RK = 2816, ZC_RV = 3328, ZC_RG = 3840, ZC_NG = 4352;

struct P {
    const float *x, *p, *g_mix, *w_in, *w_cmp_k, *w_cmp_v, *a_re, *a_im, *log_dt, *b_re, *b_im, *c_re, *c_im, *s5_d, *w_glu, *pool_w, *pool_scale,
        *w_branch, *w_out, *g_mlp, *w_up, *w_down, *w_pg, *w_pp, *g_final;
    float* h;
    unsigned char* ws;
};

DI unsigned pk2(float a, float b) { f32x2 v = {a, b}; bf16v2 r = __builtin_convertvector(v, bf16v2); return __builtin_bit_cast(unsigned, r); }
DI bf16_t f2bf(float a) { return (bf16_t)(pk2(a, 0.f) & 0xffffu); }
DI float bf2f(bf16_t x) { return __uint_as_float((unsigned)x << 16); }
DI float bflo(unsigned w) { return __uint_as_float(w << 16); }
DI float bfhi(unsigned w) { return __uint_as_float(w & 0xffff0000u); }
DI float sig255(float x) { return __builtin_amdgcn_rcpf(__builtin_fmaf(__builtin_amdgcn_exp2f(-1.4426950408889634f * x), 1.f / 255.f, 1.f / 255.f)); }
DI float sigmoidf_(float x) { return __builtin_amdgcn_rcpf(1.f + __builtin_amdgcn_exp2f(-1.4426950408889634f * x)); }
DI float gelu_tanh(float x) { float z = 0.7978845608f * (x + 0.044715f * x * x * x); float e = __expf(2.f * z); float th = 1.f - 2.f / (e + 1.f); return 0.5f * x * (1.f + th); }
DI int tidx() { int t = threadIdx.x; asm volatile("" : "+v"(t)); return t; }
DI int bidx() { int b = blockIdx.x; asm volatile("" : "+s"(b)); return b; }
DI int crow(int i, int h) { return (i & 3) + 8 * (i >> 2) + 4 * h; }
DI void wave_sync() { asm volatile("s_waitcnt lgkmcnt(0)" ::: "memory"); __builtin_amdgcn_wave_barrier(); asm volatile("" ::: "memory"); }
#define MFMA32(a, b, c) __builtin_amdgcn_mfma_f32_32x32x16_bf16((a), (b), (c), 0, 0, 0)
#define MFMA16(a, b, c) __builtin_amdgcn_mfma_f32_16x16x32_bf16((a), (b), (c), 0, 0, 0)
DI f32x16 zero16() { f32x16 z; for (int i = 0; i < 16; ++i) z[i] = 0.f; return z; }
DI bf16x8 pack8(const f32x16& x, int s) {
    u32x4 w; w.x = pk2(x[8 * s], x[8 * s + 1]); w.y = pk2(x[8 * s + 2], x[8 * s + 3]); w.z = pk2(x[8 * s + 4], x[8 * s + 5]); w.w = pk2(x[8 * s + 6], x[8 * s + 7]);
    return __builtin_bit_cast(bf16x8, w);
}
DI bf16x8 cat4(s16x4 a, s16x4 b) { return __builtin_shufflevector(a, b, 0, 1, 2, 3, 4, 5, 6, 7); }
__device__ const float LG2G[4] = {-0.04580368961f, -0.02272007651f, -0.01131531323f, -0.005646563141f};

__device__ const double ANGTAB[64] = {1.0, 0.8639884494839686, 0.746476040841712, 0.6449466771037623, 0.5572264795507174, 0.4814372420784346, 0.4159562163071847, 0.3593813663804627, 0.310501349512486, 0.2682695795279726, 0.2317818180600892, 0.20025681360431177, 0.1730195738845894, 0.14948691337092335, 0.1291549665014884, 0.11158839925077482, 0.09641108804907499, 0.08329806647658265, 0.0719685673001152, 0.06218001087320915, 0.05372281118324029, 0.046415888336127774, 0.04010279139495206, 0.034648348557303664, 0.029935772947204897, 0.02586416205275968, 0.02234633726916594, 0.019306977288832496, 0.016681005372000585, 0.014412195967188533, 0.012451970847350322, 0.01075835898542179, 0.00929509789880649, 0.008030857221391512, 0.0069385678787371825, 0.005994842503189405, 0.00517947467923121, 0.0044750062972504475, 0.003866353752192409, 0.0033404849835132425, 0.0028861404414300884, 0.002493592004984158, 0.0021544346900318825, 0.00186140668735512, 0.0016082338776670414, 0.0013894954943731372, 0.0012005080577484068, 0.0010372250954070563, 0.0008961505019466045, 0.0007742636826811268, 0.0006689548786914139, 0.0005779692884153309, 0.0004993587893473147, 0.00043144022614437797, 0.0003727593720314938, 0.000322059791872108, 0.0002782559402207124, 0.0002404099183509969, 0.0002077113925966454, 0.00017946024402973164, 0.0001550515779832623, 0.0001339627724518015, 0.00011574228805920575, 9.999999999999991e-05};
namespace pg8 {
constexpr int BM = 256, BK = 64, HALF = 128, HTB = HALF * BK * 2, NXCD = 8, WGM = 8;
DI int lds_byte(int r, int c) { const int st = (r >> 4) * 2 + (c >> 5), rr = r & 15, cc = c & 31, ob = rr * 64 + cc * 2; return st * 1024 + (ob ^ (((ob >> 9) & 1) << 5)); }
DI void stage_rc(int b, int& R, int& C) { const int st = b / 1024, sb = b % 1024, swz = sb ^ (((sb >> 9) & 1) << 5); R = (st >> 1) * 16 + swz / 64; C = (st & 1) * 32 + (swz % 64) / 2; }
DI int perm32(int rho) { const int n = rho >> 4, i = rho & 15; return 8 * (i >> 2) + 4 * n + (i & 3); }
struct Unit { int pm, pn; };
struct Gemm { const bf16_t* A; const bf16_t* Bt; int lda, K; };
struct StaticOrder {
    int nM, nN, nwg, G, c;
    DI void init(int nM_, int nN_, int G_, int c_) { nM = nM_; nN = nN_; nwg = nM * nN; G = G_; c = c_; }
    DI bool next(int i, Unit& u) const {
        const long L = (long)i * G + c; if (L >= nwg) return false;
        int wgid = (int)L; { const int q = nwg / NXCD, r = nwg % NXCD, xcd = wgid % NXCD, off = wgid / NXCD; wgid = (xcd < r ? xcd * (q + 1) : r * (q + 1) + (xcd - r) * q) + off; }
        const int nig = WGM * nN, gid = wgid / nig, fm = gid * WGM, gsz = (nM - fm) < WGM ? (nM - fm) : WGM;
        u.pm = fm + ((wgid % nig) % gsz); u.pn = (wgid % nig) / gsz; return true;
    }
};
struct BranchOrder {
    int G, c;
    DI bool next(int i, Unit& u) const {
        const int tile = (i >> 2) * G + c, j = i & 3; if (tile >= 512) return false;
        u.pm = j * 64 + (tile >> 3); u.pn = j * 8 + (tile & 7); return true;
    }
};
struct PpOrder {
    int G, c;
    DI bool next(int i, Unit& u) const {
        int L;
        if (G == 256) { if (c < 128) return false; L = i * 128 + (c - 128); } else L = i * G + c;
        if (L >= 512) return false;
        u.pm = L >> 3; u.pn = L & 7; return true;
    }
};
struct GpOrder {
    int G, c;
    DI bool next(int i, Unit& u) const {
        const int L = i * G + c; if (L >= 384) return false;
        if (L < 256) { u.pm = L >> 2; u.pn = L & 3; } else { const int l2 = L - 256; u.pm = 64 + (l2 >> 1); u.pn = 4 + (l2 & 1); }
        return true;
    }
};

template <class Epi, class Sched>
DI void gemm_phase(LAS unsigned char* lds, const Gemm g, const Sched& S, const Epi& E) {
    int tid = tidx(); asm volatile("" : "+v"(tid));
    const int wid = __builtin_amdgcn_readfirstlane(tid >> 6), lane = tid & 63, wr = wid >> 2, wc = wid & 3, fr = lane & 15, fq = lane >> 4;
    const int K = g.K, nt = K / BK, lda = g.lda;
    unsigned voffA[2], voffB[2];
#pragma unroll
    for (int i = 0; i < 2; ++i) { int R, C; stage_rc(tid * 16 + i * 8192, R, C); const int Rb = Epi::PERM ? ((R & ~31) + perm32(R & 31)) : R;
        voffA[i] = (unsigned)(R * lda + C) * 2u; voffB[i] = (unsigned)(Rb * K + C) * 2u; }
    const size_t kstep = (size_t)(BK * 2);
    const size_t hstepA = (size_t)HALF * lda * 2, hstepB = (size_t)HALF * K * 2;
    const size_t tstepA = 2 * hstepA, tstepB = 2 * hstepB;
    const unsigned ldsw = (unsigned)wid * 1024u;
    const int aoff = lds_byte(wr * 64 + fr, fq * 8), boff = lds_byte(wc * 32 + fr, fq * 8);
#define PG8_SA(b, h) (((b) * 2 + (h)) * HTB)
#define PG8_SB(b, h) ((4 + (b) * 2 + (h)) * HTB)
#define PG8_STAGE(bufoff, gbase, voff) do { _Pragma("unroll") for (int _i = 0; _i < 2; ++_i) \
        __builtin_amdgcn_global_load_lds((const unsigned*)((const char*)(gbase) + (voff)[_i]), (LAS unsigned*)(lds + (bufoff) + ldsw + _i * 8192), 16, 0, 0); } while (0)
#define PG8_LDA(dst, b, h) do { _Pragma("unroll") for (int m = 0; m < 4; ++m) _Pragma("unroll") for (int k = 0; k < 2; ++k) dst[m][k] = *(const LAS bf16x8*)(lds + PG8_SA(b, h) + aoff + m * 2048 + k * 1024); } while (0)
#define PG8_LDB(dst, b, h) do { _Pragma("unroll") for (int n = 0; n < 2; ++n) _Pragma("unroll") for (int k = 0; k < 2; ++k) dst[n][k] = *(const LAS bf16x8*)(lds + PG8_SB(b, h) + boff + n * 2048 + k * 1024); } while (0)
#define PG8_MMA(ai, bj, At, Bt) do { __builtin_amdgcn_s_setprio(1); _Pragma("unroll") for (int m = 0; m < 4; ++m) _Pragma("unroll") for (int n = 0; n < 2; ++n) _Pragma("unroll") for (int k = 0; k < 2; ++k) \
        acc[ai][bj][m][n] = __builtin_amdgcn_mfma_f32_16x16x32_bf16(Bt[n][k], At[m][k], acc[ai][bj][m][n], 0, 0, 0); __builtin_amdgcn_s_setprio(0); } while (0)
#define PG8_WAIT_V(n) asm volatile("s_waitcnt vmcnt(" #n ")" ::: "memory")
#define PG8_WAIT_L(n) asm volatile("s_waitcnt lgkmcnt(" #n ")" ::: "memory")
#define PG8_BAR __builtin_amdgcn_s_barrier()
#define PG8_SCHED __builtin_amdgcn_sched_barrier(0)
    Unit cur, nxt; int ui = 0;
    if (!S.next(0, cur)) return;
    f32x4 acc[2][2][4][2];
#pragma unroll
    for (int a = 0; a < 2; ++a)
#pragma unroll
        for (int b = 0; b < 2; ++b)
#pragma unroll
            for (int m = 0; m < 4; ++m)
#pragma unroll
                for (int n = 0; n < 2; ++n) acc[a][b][m][n] = (f32x4){0.f, 0.f, 0.f, 0.f};
    bf16x8 At[4][2], B0[2][2], B1[2][2];
    const char* cA = (const char*)g.A + (size_t)cur.pm * tstepA; const char* cB = (const char*)g.Bt + (size_t)cur.pn * tstepB;
    PG8_STAGE(PG8_SB(0, 0), cB, voffB); PG8_STAGE(PG8_SA(0, 0), cA, voffA); PG8_STAGE(PG8_SB(0, 1), cB + hstepB, voffB); PG8_STAGE(PG8_SA(0, 1), cA + hstepA, voffA);
    if (wr == 1) PG8_BAR;
    PG8_WAIT_V(4); PG8_BAR;
    PG8_STAGE(PG8_SB(1, 0), cB + kstep, voffB); PG8_STAGE(PG8_SA(1, 0), cA + kstep, voffA); PG8_STAGE(PG8_SB(1, 1), cB + hstepB + kstep, voffB);
    PG8_WAIT_V(6); PG8_BAR;
    for (;;) {
        const bool has_next = S.next(ui + 1, nxt);
        const char* nA = has_next ? (const char*)g.A + (size_t)nxt.pm * tstepA : cA; const char* nB = has_next ? (const char*)g.Bt + (size_t)nxt.pn * tstepB : cB;
        for (int t = 0; t < nt; t += 2) {
            const bool last = (t == nt - 2);
            const char* a1 = cA + (size_t)(t + 1) * kstep;
            const char* a2 = last ? nA : cA + (size_t)(t + 2) * kstep; const char* b2 = last ? nB : cB + (size_t)(t + 2) * kstep;
            const char* a3 = a2 + kstep; const char* b3 = b2 + kstep;
            PG8_LDB(B0, 0, 0); PG8_SCHED; PG8_LDA(At, 0, 0); PG8_STAGE(PG8_SA(1, 1), a1 + hstepA, voffA);
            PG8_WAIT_L(8); PG8_BAR; PG8_WAIT_L(0); PG8_MMA(0, 0, At, B0); PG8_BAR; PG8_SCHED;
            PG8_LDB(B1, 0, 1); PG8_STAGE(PG8_SB(0, 0), b2, voffB);
            PG8_BAR; PG8_WAIT_L(0); PG8_MMA(0, 1, At, B1); PG8_BAR;
            PG8_LDA(At, 0, 1); PG8_STAGE(PG8_SA(0, 0), a2, voffA);
            PG8_BAR; PG8_WAIT_L(0); PG8_MMA(1, 0, At, B0); PG8_BAR; PG8_SCHED;
            PG8_STAGE(PG8_SB(0, 1), b2 + hstepB, voffB);
            PG8_WAIT_V(6); PG8_BAR; PG8_MMA(1, 1, At, B1); PG8_BAR;
            PG8_LDB(B0, 1, 0); PG8_SCHED; PG8_LDA(At, 1, 0); PG8_STAGE(PG8_SA(0, 1), a2 + hstepA, voffA);
            PG8_WAIT_L(8); PG8_BAR; PG8_WAIT_L(0); PG8_MMA(0, 0, At, B0); PG8_BAR; PG8_SCHED;
            PG8_LDB(B1, 1, 1); PG8_STAGE(PG8_SB(1, 0), b3, voffB);
            PG8_BAR; PG8_WAIT_L(0); PG8_MMA(0, 1, At, B1); PG8_BAR;
            PG8_LDA(At, 1, 1); PG8_STAGE(PG8_SA(1, 0), a3, voffA);
            PG8_BAR; PG8_WAIT_L(0); PG8_MMA(1, 0, At, B0); PG8_BAR; PG8_SCHED;
            PG8_STAGE(PG8_SB(1, 1), b3 + hstepB, voffB);
            PG8_WAIT_V(6); PG8_BAR; PG8_MMA(1, 1, At, B1); PG8_BAR;
            if constexpr (Epi::HOOK) { if ((t & 7) == 6 && !last) E.hook(acc, cur, t >> 3, wr, wc, fr, fq); }
        }
        E(acc, cur, wr, wc, fr, fq);
        if (Epi::REPEAT) { asm volatile("" ::: "memory"); E(acc, cur, wr, wc, fr, fq); }
        if (!has_next) break;
#pragma unroll
        for (int a = 0; a < 2; ++a)
#pragma unroll
            for (int b = 0; b < 2; ++b)
#pragma unroll
                for (int m = 0; m < 4; ++m)
#pragma unroll
                    for (int n = 0; n < 2; ++n) acc[a][b][m][n] = (f32x4){0.f, 0.f, 0.f, 0.f};
        cur = nxt; cA = nA; cB = nB; ++ui;
    }
    PG8_WAIT_V(0);
    if (wr == 0) PG8_BAR;
    PG8_BAR;
#undef PG8_SA
#undef PG8_SB
#undef PG8_STAGE
#undef PG8_LDA
#undef PG8_LDB
#undef PG8_MMA
#undef PG8_WAIT_V
#undef PG8_WAIT_L
#undef PG8_BAR
#undef PG8_SCHED
}

typedef const f32x4 (&AccT)[2][2][4][2];
DI unsigned q8(float x) { return (unsigned)(sigmoidf_(x) * 255.f + 0.5f); }

struct EpiIn {
    static constexpr bool PERM = true, REPEAT = false, HOOK = false;
    bf16_t* Zm; unsigned char* G8; const f32x2* trig; const float* ss;
    DI void operator()(AccT acc0, const Unit& u, int wr, int wc, int fr, int fq) const {
        const int row0 = u.pm * 256 + wr * 64 + fr, cw = wc * 32 + 8 * fq;
        f32x4 acc[2][2][4][2];
#pragma unroll
        for (int ai = 0; ai < 2; ++ai)
#pragma unroll
            for (int m = 0; m < 4; ++m) { const float rs = ss ? rsqrtf(ss[row0 + ai * 128 + m * 16] * (1.f / 2048.f) + 1e-6f) : 1.f;
#pragma unroll
                for (int bj = 0; bj < 2; ++bj)
#pragma unroll
                    for (int n = 0; n < 2; ++n) acc[ai][bj][m][n] = acc0[ai][bj][m][n] * rs; }
        if (u.pn >= 18) {
            unsigned char* tb = G8 + ((size_t)u.pm * 32 + (u.pn - 18)) * 65536 + (size_t)((wr * 4 + wc) * 64 + fq * 16 + fr) * 16;
#pragma unroll
            for (int ai = 0; ai < 2; ++ai)
#pragma unroll
                for (int m = 0; m < 4; ++m) { unsigned char* rp = tb + (size_t)(ai * 4 + m) * 8192; unsigned ga_[2], gb_[2];
#pragma unroll
                    for (int bj = 0; bj < 2; ++bj) { const f32x4 v0 = acc[ai][bj][m][0], v1 = acc[ai][bj][m][1]; u32x2 w; unsigned a = 0u, b = 0u;
#pragma unroll
                        for (int j = 0; j < 4; ++j) { a = __builtin_amdgcn_cvt_pk_u8_f32(__builtin_rintf(sig255(v0[j])), j, a); b = __builtin_amdgcn_cvt_pk_u8_f32(__builtin_rintf(sig255(v1[j])), j, b); }
                        (void)w; ga_[bj] = a; gb_[bj] = b; }
                    *(u32x4*)rp = (u32x4){ga_[0], gb_[0], ga_[1], gb_[1]}; }
        } else {
            const int mode = (u.pn == 17) ? 2 : ((u.pn >= 9 && u.pn <= 12) ? 1 : 0);
            const float ksc = (u.pn >= 11) ? 0.08838834764831845f : 1.f;
#pragma unroll
            for (int ai = 0; ai < 2; ++ai)
#pragma unroll
                for (int m = 0; m < 4; ++m) { const int row = row0 + ai * 128 + m * 16; bf16_t* rp = Zm + (size_t)row * ZW + u.pn * 256 + cw;
                    f32x2 cs[4];
                    if (mode == 1) { const f32x4* tp = (const f32x4*)(trig + (size_t)row * 64 + (cw >> 1)); const f32x4 t0 = tp[0], t1 = tp[1];
                        cs[0] = (f32x2){t0[0], t0[1]}; cs[1] = (f32x2){t0[2], t0[3]}; cs[2] = (f32x2){t1[0], t1[1]}; cs[3] = (f32x2){t1[2], t1[3]}; }
#pragma unroll
                    for (int bj = 0; bj < 2; ++bj) { f32x4 v0 = acc[ai][bj][m][0], v1 = acc[ai][bj][m][1];
                        if (mode == 1) {
                            f32x4 r0, r1;
                            r0[0] = (v0[0] * cs[0].x - v0[1] * cs[0].y) * ksc; r0[1] = (v0[1] * cs[0].x + v0[0] * cs[0].y) * ksc;
                            r0[2] = (v0[2] * cs[1].x - v0[3] * cs[1].y) * ksc; r0[3] = (v0[3] * cs[1].x + v0[2] * cs[1].y) * ksc;
                            r1[0] = (v1[0] * cs[2].x - v1[1] * cs[2].y) * ksc; r1[1] = (v1[1] * cs[2].x + v1[0] * cs[2].y) * ksc;
                            r1[2] = (v1[2] * cs[3].x - v1[3] * cs[3].y) * ksc; r1[3] = (v1[3] * cs[3].x + v1[2] * cs[3].y) * ksc;
                            v0 = r0; v1 = r1;
                        } else if (mode == 2) {
#pragma unroll
                            for (int j = 0; j < 4; ++j) { v0[j] = sigmoidf_(v0[j]); v1[j] = sigmoidf_(v1[j]); }
                        }
                        u32x4 w; w.x = pk2(v0[0], v0[1]); w.y = pk2(v0[2], v0[3]); w.z = pk2(v1[0], v1[1]); w.w = pk2(v1[2], v1[3]);
                        *(u32x4*)(rp + bj * 128) = w; } }
        }
    }
};
#ifndef REP_EPI
#define REP_EPI 0
#endif
template <int ACT> struct EpiBf {
    static constexpr bool PERM = true, REPEAT = (REP_EPI != 0) && (ACT == 1), HOOK = false;
    bf16_t* O; int ldc; const float* ss;
    DI void operator()(AccT acc, const Unit& u, int wr, int wc, int fr, int fq) const {
        const int row0 = u.pm * 256 + wr * 64 + fr, col0 = u.pn * 256 + wc * 32 + 8 * fq;
#pragma unroll
        for (int ai = 0; ai < 2; ++ai)
#pragma unroll
            for (int m = 0; m < 4; ++m) { bf16_t* rp = O + (size_t)(row0 + ai * 128 + m * 16) * ldc + col0;
                const float rs = ss ? rsqrtf(ss[row0 + ai * 128 + m * 16] * (1.f / 2048.f) + 1e-6f) : 1.f;
#pragma unroll
                for (int bj = 0; bj < 2; ++bj) { f32x4 v0 = acc[ai][bj][m][0] * rs, v1 = acc[ai][bj][m][1] * rs;
                    if (ACT == 1) {
#pragma unroll
                        for (int j = 0; j < 4; ++j) { float a = fmaxf(v0[j], 0.f), b = fmaxf(v1[j], 0.f); v0[j] = a * a; v1[j] = b * b; } }
                    u32x4 w; w.x = pk2(v0[0], v0[1]); w.y = pk2(v0[2], v0[3]); w.z = pk2(v1[0], v1[1]); w.w = pk2(v1[2], v1[3]);
                    *(u32x4*)(rp + bj * 128) = w; } }
    }
};
struct EpiGp {
    static constexpr bool PERM = true, REPEAT = false, HOOK = false;
    bf16_t* Os5; bf16_t* Opool; const float* pscale;
    DI void operator()(AccT acc, const Unit& u, int wr, int wc, int fr, int fq) const {
        const int cw = wc * 32 + 8 * fq;
        if (u.pm < 64) {
            const int row0 = u.pm * 256 + wr * 64 + fr, ch0 = u.pn * 128 + cw;
#pragma unroll
            for (int ai = 0; ai < 2; ++ai)
#pragma unroll
                for (int m = 0; m < 4; ++m) { bf16_t* rp = Os5 + (size_t)(row0 + ai * 128 + m * 16) * 2048 + ch0;
                    const f32x4 a0 = acc[ai][0][m][0], a1 = acc[ai][0][m][1], b0 = acc[ai][1][m][0], b1 = acc[ai][1][m][1]; f32x4 v0, v1;
#pragma unroll
                    for (int j = 0; j < 4; ++j) { v0[j] = a0[j] * sigmoidf_(b0[j]); v1[j] = a1[j] * sigmoidf_(b1[j]); }
                    u32x4 w; w.x = pk2(v0[0], v0[1]); w.y = pk2(v0[2], v0[3]); w.z = pk2(v1[0], v1[1]); w.w = pk2(v1[2], v1[3]);
                    *(u32x4*)rp = w; }
        } else {
            const int row0 = (u.pm - 64) * 256 + wr * 64 + fr, col0 = (u.pn - 4) * 256 + cw;
#pragma unroll
            for (int bj = 0; bj < 2; ++bj) { const f32x4 s0 = *(const f32x4*)(pscale + col0 + bj * 128), s1 = *(const f32x4*)(pscale + col0 + bj * 128 + 4);
#pragma unroll
                for (int ai = 0; ai < 2; ++ai)
#pragma unroll
                    for (int m = 0; m < 4; ++m) { bf16_t* rp = Opool + (size_t)(row0 + ai * 128 + m * 16) * 2048 + col0 + bj * 128;
                        const f32x4 v0 = acc[ai][bj][m][0] * s0, v1 = acc[ai][bj][m][1] * s1;
                        u32x4 w; w.x = pk2(v0[0], v0[1]); w.y = pk2(v0[2], v0[3]); w.z = pk2(v1[0], v1[1]); w.w = pk2(v1[2], v1[3]);
                        *(u32x4*)rp = w; } }
        }
    }
};
struct EpiBr {
    static constexpr bool PERM = true, REPEAT = false, HOOK = true;
    const unsigned char* G8; bf16_t* Mb;
    DI static f32x4 unpack(unsigned gq) { f32x4 gv; gv[0] = (float)(gq & 255u); gv[1] = (float)((gq >> 8) & 255u); gv[2] = (float)((gq >> 16) & 255u); gv[3] = (float)(gq >> 24);
        gv[0] = fmaxf(gv[0], 1.f); gv[1] = fmaxf(gv[1], 1.f); gv[2] = fmaxf(gv[2], 1.f); gv[3] = fmaxf(gv[3], 1.f); return gv; }
    DI void hook(f32x4 (&acc)[2][2][4][2], const Unit& u, int j, int wr, int wc, int fr, int fq) const {
        int tix = ((wr * 4 + wc) * 64 + fq * 16 + fr) * 16;
        asm volatile("" : "+v"(tix));
        const unsigned char* ta = G8 + ((size_t)u.pm * 32 + j * 8 + u.pn) * 65536 + tix;
#pragma unroll
        for (int ai = 0; ai < 2; ++ai)
#pragma unroll
            for (int m = 0; m < 4; ++m) { const u32x4 qa = *(const u32x4*)(ta + (ai * 4 + m) * 8192), qb = *(const u32x4*)(ta + 8 * 65536 + (ai * 4 + m) * 8192);
#pragma unroll
                for (int bj = 0; bj < 2; ++bj)
#pragma unroll
                    for (int n = 0; n < 2; ++n) { const f32x4 ga = unpack(qa[bj * 2 + n]), gb = unpack(qb[bj * 2 + n]);
                        f32x4 r; r[0] = ga[0] * __builtin_amdgcn_rcpf(gb[0]); r[1] = ga[1] * __builtin_amdgcn_rcpf(gb[1]); r[2] = ga[2] * __builtin_amdgcn_rcpf(gb[2]); r[3] = ga[3] * __builtin_amdgcn_rcpf(gb[3]);
                        acc[ai][bj][m][n] = acc[ai][bj][m][n] * r; }
                if (m == 3) asm volatile("" ::: "memory"); }
    }
    DI void operator()(AccT acc, const Unit& u, int wr, int wc, int fr, int fq) const {
        const int row0 = u.pm * 256 + wr * 64 + fr, col0 = u.pn * 256 + wc * 32 + 8 * fq;
#pragma unroll
        for (int ai = 0; ai < 2; ++ai)
#pragma unroll
            for (int m = 0; m < 4; ++m) { const int row = row0 + ai * 128 + m * 16;
                const u32x4 q3 = *(const u32x4*)(G8 + ((size_t)u.pm * 32 + 24 + u.pn) * 65536 + (size_t)((ai * 4 + m) * 512 + (wr * 4 + wc) * 64 + fq * 16 + fr) * 16);
#pragma unroll
                for (int bj = 0; bj < 2; ++bj) { const f32x4 v0 = acc[ai][bj][m][0] * unpack(q3[bj * 2]) * (1.f / 255.f), v1 = acc[ai][bj][m][1] * unpack(q3[bj * 2 + 1]) * (1.f / 255.f);
                    u32x4 w; w.x = pk2(v0[0], v0[1]); w.y = pk2(v0[2], v0[3]); w.z = pk2(v1[0], v1[1]); w.w = pk2(v1[2], v1[3]); *(u32x4*)(Mb + (size_t)row * DM + col0 + bj * 128) = w; }
                if (m == 3) asm volatile("" ::: "memory"); }
    }
};
template <int MODE> struct EpiH {
    static constexpr bool PERM = true, REPEAT = false, HOOK = false;
    const float* hin; float* h; bf16_t* hb; const bf16_t* pp; bf16_t* vn; const float* gw; float* ss;
    DI void operator()(AccT acc, const Unit& u, int wr, int wc, int fr, int fq) const {
        const int row0 = u.pm * 256 + wr * 64 + fr, col0 = u.pn * 256 + wc * 32 + 8 * fq;
        f32x4 gv[2][2];
        if (vn) {
#pragma unroll
            for (int bj = 0; bj < 2; ++bj)
#pragma unroll
                for (int n = 0; n < 2; ++n) gv[bj][n] = *(const f32x4*)(gw + col0 + bj * 128 + 4 * n);
        }
#pragma unroll
        for (int ai = 0; ai < 2; ++ai)
#pragma unroll
            for (int m = 0; m < 4; ++m) { const int row = row0 + ai * 128 + m * 16; const size_t ro = (size_t)row * DM + col0; float sq = 0.f;
#pragma unroll
                for (int bj = 0; bj < 2; ++bj) { const size_t o = ro + bj * 128; f32x4 a0 = acc[ai][bj][m][0], a1 = acc[ai][bj][m][1];
                    if (MODE == 2) { const u32x4 pw = *(const u32x4*)(pp + o);
                        a0[0] = sigmoidf_(a0[0]) * bflo(pw.x); a0[1] = sigmoidf_(a0[1]) * bfhi(pw.x); a0[2] = sigmoidf_(a0[2]) * bflo(pw.y); a0[3] = sigmoidf_(a0[3]) * bfhi(pw.y);
                        a1[0] = sigmoidf_(a1[0]) * bflo(pw.z); a1[1] = sigmoidf_(a1[1]) * bfhi(pw.z); a1[2] = sigmoidf_(a1[2]) * bflo(pw.w); a1[3] = sigmoidf_(a1[3]) * bfhi(pw.w); }
                    const f32x4 v0 = *(const f32x4*)(hin + o) + a0, v1 = *(const f32x4*)(hin + o + 4) + a1;
                    *(f32x4*)(h + o) = v0; *(f32x4*)(h + o + 4) = v1;
                    if (MODE == 1) { u32x4 w; w.x = pk2(v0[0], v0[1]); w.y = pk2(v0[2], v0[3]); w.z = pk2(v1[0], v1[1]); w.w = pk2(v1[2], v1[3]); *(u32x4*)(hb + o) = w; }
                    if (vn) { sq += ((v0[0] * v0[0] + v0[1] * v0[1]) + (v0[2] * v0[2] + v0[3] * v0[3])) + ((v1[0] * v1[0] + v1[1] * v1[1]) + (v1[2] * v1[2] + v1[3] * v1[3]));
                        const f32x4 y0 = v0 * gv[bj][0], y1 = v1 * gv[bj][1]; u32x4 w; w.x = pk2(y0[0], y0[1]); w.y = pk2(y0[2], y0[3]); w.z = pk2(y1[0], y1[1]); w.w = pk2(y1[2], y1[3]); *(u32x4*)(vn + o) = w; } }
                if (vn) { sq += __shfl_xor(sq, 16); sq += __shfl_xor(sq, 32); if (fq == 0) atomicAdd(ss + row, sq); }
                if (m == 3) asm volatile("" ::: "memory"); }
    }
};
}

DI int map_in(int n) { if (n < 1280) return n; if (n < 4352) return n + 24; if (n < 4376) return n - 4352 + 1280; if (n < 4608) return -1; return n - 4608 + 4376; }
DI f32x4 wsrc4(const P& p, int L, int task, int n, int k) {
    const float* q = nullptr;
    switch (task) {
    case 0: { const int c = map_in(n); q = c < 0 ? nullptr : p.w_in + ((size_t)L * 2048 + k) * 12568 + c; break; }
    case 1: q = p.w_up + ((size_t)L * 2048 + k) * 8192 + n; break;
    case 2: q = p.w_down + ((size_t)L * 8192 + k) * 2048 + n; break;
    case 3: q = p.w_out + ((size_t)L * 2048 + k) * 2048 + n; break;
    case 4: q = p.w_pg + ((size_t)L * 2048 + k) * 2048 + n; break;
    case 5: q = p.w_branch + ((size_t)L * 2048 + k) * 2048 + n; break;
    case 6: q = p.w_pp + ((size_t)L * 256 + k) * 2048 + n; break;
    case 7: { if (n < 1024) { const int tile = n >> 8, half = (n >> 7) & 1, ch = tile * 128 + (n & 127); q = p.w_glu + ((size_t)L * 512 + k) * 1024 + half * 512 + ch; }
              else { const int c = n - 1024; q = ((k >> 7) == (c >> 7)) ? p.pool_w + (((size_t)L * 4 + (c >> 7)) * 128 + (k & 127)) * 128 + (c & 127) : nullptr; } break; }
    default: { const int kv = n >> 6, e = n & 63; q = (kv ? p.w_cmp_v : p.w_cmp_k) + ((size_t)L * 2048 + k) * 64 + e; break; }
    }
    return q ? *(const f32x4*)q : (f32x4){0.f, 0.f, 0.f, 0.f};
}
DI void conv_phase(const P& p, int L, unsigned char* lds) {
    float* T = (float*)lds;
    const int tid = tidx();
    const int tcnt[9] = {3200, 2048, 2048, 512, 512, 512, 64, 96, 32};
    const int tK[9] = {2048, 2048, 8192, 2048, 2048, 2048, 256, 512, 2048};
    const size_t toff[9] = {OFF_WIN, OFF_WUP, OFF_WDN, OFF_WOUT, OFF_WPG, OFF_WBR, OFF_WPP, OFF_WGP, OFF_WCMP};
    const int nn4 = (tid & 31) * 4, kk = tid >> 5, r = tid >> 2, cq = (tid & 3) * 8;
    for (int it = bidx(); it < 9024; it += gridDim.x) {
        int task = 0, ti = it;
#pragma unroll
        for (int q = 0; q < 8; ++q) if (task == q && ti >= tcnt[q]) { ti -= tcnt[q]; task = q + 1; }
        int K = 0; size_t off = 0;
#pragma unroll
        for (int q = 0; q < 9; ++q) if (task == q) { K = tK[q]; off = toff[q]; }
        const int nkt = K >> 6, n0 = (ti / nkt) * 128, k0 = (ti % nkt) * 64;
        f32x4 v[4];
#pragma unroll
        for (int i = 0; i < 4; ++i) v[i] = wsrc4(p, L, task, n0 + nn4, k0 + kk + 16 * i);
#pragma unroll
        for (int i = 0; i < 4; ++i) *(f32x4*)(T + (kk + 16 * i) * 132 + nn4) = v[i];
        __syncthreads();
#pragma unroll
        for (int ps = 0; ps < 2; ++ps) { const int c8 = cq + 32 * ps;
            u32x4 w; w.x = pk2(T[(c8 + 0) * 132 + r], T[(c8 + 1) * 132 + r]); w.y = pk2(T[(c8 + 2) * 132 + r], T[(c8 + 3) * 132 + r]);
            w.z = pk2(T[(c8 + 4) * 132 + r], T[(c8 + 5) * 132 + r]); w.w = pk2(T[(c8 + 6) * 132 + r], T[(c8 + 7) * 132 + r]);
            *(u32x4*)((bf16_t*)(p.ws + off) + (size_t)(n0 + r) * K + k0 + c8) = w; }
        __syncthreads();
    }
}
DI float red2pi(double a) { return (float)(a - 6.283185307179586 * rint(a * 0.15915494309189535)); }
DI void misc_prep(const P& p, int L) {
    const int gt = bidx() * 512 + tidx(), gs = gridDim.x * 512;
    { const f32x4* src = (const f32x4*)(p.p + (size_t)L * S * 256); u32x2* dst = (u32x2*)(p.ws + OFF_PBF);
      for (int i = gt; i < S * 64; i += gs) { const f32x4 v = src[i]; u32x2 w; w.x = pk2(v[0], v[1]); w.y = pk2(v[2], v[3]); dst[i] = w; } }
    if (L == 0) { f32x2* tr = (f32x2*)(p.ws + OFF_TRIG);
      for (int i = gt; i < S * 64; i += gs) { const int t = i >> 6, k = i & 63; const double ang = (double)t * ANGTAB[k];
          const float r = red2pi(ang); tr[i] = (f32x2){cosf(r), sinf(r)}; } }
    if (gt < 2048) {
        float* sp = (float*)(p.ws + OFF_S5P); const int g = gt >> 6;
        const float dt = expf(p.log_dt[L * 32 + g]), are = p.a_re[L * 2048 + gt], aim = p.a_im[L * 2048 + gt];
        const float mag = expf(are * dt), ph = red2pi((double)aim * (double)dt);
        float ar = mag * cosf(ph), ai = mag * sinf(ph);
        sp[gt] = ar; sp[2048 + gt] = ai;
        const float xr = ar - 1.f, xi = ai, den = 1.f / (are * are + aim * aim);
        const float cr = (xr * are + xi * aim) * den, ci = (xi * are - xr * aim) * den;
        for (int c = 0; c < 16; ++c) { const float br = p.b_re[((size_t)L * 2048 + gt) * 16 + c], bi = p.b_im[((size_t)L * 2048 + gt) * 16 + c];
            sp[8192 + gt * 16 + c] = cr * br - ci * bi; sp[8192 + 32768 + gt * 16 + c] = cr * bi + ci * br; }
        for (int q = 0; q < 7; ++q) { const float nr = ar * ar - ai * ai, ni = 2.f * ar * ai; ar = nr; ai = ni; }
        sp[4096 + gt] = ar; sp[6144 + gt] = ai;
    }
}
template <bool COPY, bool FINAL>
DI void norm_phase(const float* src, float* hcopy, const float* gw, bf16_t* ob, float* of) {
    const int lane = tidx() & 63, wv = bidx() * 8 + (tidx() >> 6), nw = gridDim.x * 8;
    for (int row = wv; row < S; row += nw) {
        const f32x4* sp = (const f32x4*)(src + (size_t)row * DM); f32x4 v[8]; float ss = 0.f;
#pragma unroll
        for (int i = 0; i < 8; ++i) { v[i] = sp[lane + 64 * i]; ss += v[i][0] * v[i][0] + v[i][1] * v[i][1] + v[i][2] * v[i][2] + v[i][3] * v[i][3]; }
#pragma unroll
        for (int o = 32; o > 0; o >>= 1) ss += __shfl_xor(ss, o);
        const float rs = rsqrtf(ss * (1.f / 2048.f) + 1e-6f);
#pragma unroll
        for (int i = 0; i < 8; ++i) { const f32x4 gv = ((const f32x4*)gw)[lane + 64 * i]; const f32x4 y = v[i] * rs * gv;
            if (COPY) ((f32x4*)(hcopy + (size_t)row * DM))[lane + 64 * i] = v[i];
            if (FINAL) ((f32x4*)(of + (size_t)row * DM))[lane + 64 * i] = y;
            else { u32x2 w; w.x = pk2(y[0], y[1]); w.y = pk2(y[2], y[3]); ((u32x2*)(ob + (size_t)row * DM))[lane + 64 * i] = w; } }
    }
}

DI void compress_phase(const P& p, unsigned char* lds) {
    const int tid = tidx(), w = tid >> 6, lane = tid & 63, ql = lane & 31, hh = lane >> 5;
    const bf16_t* Zm = (const bf16_t*)(p.ws + OFF_ZM); const bf16_t* Wc = (const bf16_t*)(p.ws + OFF_WCMP);
    bf16_t* KC = (bf16_t*)(p.ws + OFF_KC); bf16_t* VCT = (bf16_t*)(p.ws + OFF_VCT);
    float* red = (float*)lds;
    for (int task = bidx(); task < 256; task += gridDim.x) {
        const int et = task & 1, ntile = (task >> 1) & 31, g = (task >> 6) & 1, kv = task >> 7;
        const bf16_t* ap = Zm + (size_t)(16 * (ntile * 32 + ql)) * ZW + ZC_KV + kv * 128 + g * 64 + 8 * hh;
        const bf16_t* bp = Wc + (size_t)(kv * 64 + et * 32 + ql) * 2048 + 8 * hh;
        f32x16 acc = zero16();
#pragma unroll 8
        for (int s = 16 * w; s < 16 * w + 16; ++s) { const bf16x8 a = *(const bf16x8*)(ap + (size_t)(s >> 2) * ZW + 16 * (s & 3)); const bf16x8 b = *(const bf16x8*)(bp + 16 * s); acc = MFMA32(a, b, acc); }
#pragma unroll
        for (int i = 0; i < 16; ++i) red[(w * 16 + i) * 64 + lane] = acc[i];
        __syncthreads();
        if (w == 0) {
#pragma unroll
            for (int i = 0; i < 16; ++i) { float t = 0.f;
#pragma unroll
                for (int q = 0; q < 8; ++q) t += red[(q * 16 + i) * 64 + lane];
                acc[i] = t; }
            const int e = et * 32 + ql;
            if (kv == 0) {
#pragma unroll
                for (int i = 0; i < 16; ++i) { const int n = ntile * 32 + crow(i, hh); KC[((size_t)g * 1024 + n) * 64 + e] = (n < 1023) ? f2bf(acc[i]) : (bf16_t)0; }
            } else {
#pragma unroll
                for (int gi = 0; gi < 4; ++gi) { const int n = ntile * 32 + 8 * gi + 4 * hh; u32x2 wv; wv.x = pk2(acc[4 * gi], acc[4 * gi + 1]); wv.y = pk2(acc[4 * gi + 2], (n + 3 < 1023) ? acc[4 * gi + 3] : 0.f);
                    *(u32x2*)(VCT + ((size_t)g * 64 + e) * 1024 + n) = wv; }
            }
        }
        __syncthreads();
    }
}
DI void vt_pool_phase(const P& p) {
    const bf16_t* Zm = (const bf16_t*)(p.ws + OFF_ZM);
    const int gt = bidx() * 512 + tidx(), gs = gridDim.x * 512;
    bf16_t* VT = (bf16_t*)(p.ws + OFF_VT);
    for (int i = gt; i < 4 * 64 * 2048; i += gs) { const int d = i & 63, t8 = (i >> 6) & 2047, bg = i >> 17; const int br = bg >> 1, g = bg & 1;
        const bf16_t* sp = Zm + (size_t)(t8 * 8) * ZW + ZC_KV + (3 + 2 * br) * 128 + g * 64 + d; unsigned short v[8];
#pragma unroll
        for (int j = 0; j < 8; ++j) v[j] = sp[(size_t)j * ZW];
        u32x4 w; w.x = v[0] | ((unsigned)v[1] << 16); w.y = v[2] | ((unsigned)v[3] << 16); w.z = v[4] | ((unsigned)v[5] << 16); w.w = v[6] | ((unsigned)v[7] << 16);
        *(u32x4*)(VT + ((size_t)bg * 64 + d) * S + t8 * 8) = w; }
    bf16_t* DP = (bf16_t*)(p.ws + OFF_R2) + (size_t)S * 512;
    for (int i = gt; i < S * 64; i += gs) { const int c8 = (i & 63) * 8, t = i >> 6, w = 2 << (c8 >> 7); const int cnt = (t + 1 < w) ? t + 1 : w;
        float sum[8];
#pragma unroll
        for (int j = 0; j < 8; ++j) sum[j] = 0.f;
        u32x4 self = {0, 0, 0, 0};
        for (int q = 0; q < cnt; ++q) { const u32x4 v = *(const u32x4*)(Zm + (size_t)(t - q) * ZW + ZC_POOL + c8); if (q == 0) self = v;
            sum[0] += bflo(v.x); sum[1] += bfhi(v.x); sum[2] += bflo(v.y); sum[3] += bfhi(v.y); sum[4] += bflo(v.z); sum[5] += bfhi(v.z); sum[6] += bflo(v.w); sum[7] += bfhi(v.w); }
        const float ic = 1.f / (float)cnt; u32x4 o;
        o.x = pk2(sum[0] * ic - bflo(self.x), sum[1] * ic - bfhi(self.x)); o.y = pk2(sum[2] * ic - bflo(self.y), sum[3] * ic - bfhi(self.y));
        o.z = pk2(sum[4] * ic - bflo(self.z), sum[5] * ic - bfhi(self.z)); o.w = pk2(sum[6] * ic - bflo(self.w), sum[7] * ic - bfhi(self.w));
        *(u32x4*)(DP + (size_t)t * 512 + c8) = o; }
}

DI void s5_wave(const P& p, int L, unsigned char* wl, int g, int c, bool out) {
    const int lane = tidx() & 63, ql = lane & 31, hh = lane >> 5;
    float* us = (float*)wl; bf16_t* Hs = (bf16_t*)(wl + 8192);
    const float* sp = (const float*)(p.ws + OFF_S5P); const bf16_t* Zm = (const bf16_t*)(p.ws + OFF_ZM);
    const int gn0 = g * 64 + ql, gn1 = gn0 + 32;
    const float ar0 = sp[gn0], ai0 = sp[2048 + gn0], ar1 = sp[gn1], ai1 = sp[2048 + gn1];
    bf16x8 Bf[4];
#pragma unroll
    for (int ct = 0; ct < 4; ++ct) { const float* bp = sp + 8192 + (ct >> 1) * 32768 + (g * 64 + (ct & 1) * 32 + ql) * 16 + 8 * hh; const f32x4 x = *(const f32x4*)bp, y = *(const f32x4*)(bp + 4);
        u32x4 w; w.x = pk2(x[0], x[1]); w.y = pk2(x[2], x[3]); w.z = pk2(y[0], y[1]); w.w = pk2(y[2], y[3]); Bf[ct] = __builtin_bit_cast(bf16x8, w); }
    const bf16_t* Zu = Zm + (size_t)(c * 128) * ZW + ZC_S5 + g * 16;
    float h0r = 0.f, h0i = 0.f, h1r = 0.f, h1i = 0.f;
    f32x2* E = (f32x2*)(p.ws + OFF_S5E) + (size_t)g * 128 * 64;
    bf16x8 Cf[4]; f32x4 dsk4 = {0.f, 0.f, 0.f, 0.f};
    if (out) {
#pragma unroll
        for (int i = 0; i < 4; ++i) { const int e = lane + 64 * i, t = e >> 1, hf = e & 1; const u32x4 v = *(const u32x4*)(Zu + (size_t)t * ZW + hf * 8);
            *(f32x4*)(us + t * 16 + hf * 8) = (f32x4){bflo(v.x), bfhi(v.x), bflo(v.y), bfhi(v.y)}; *(f32x4*)(us + t * 16 + hf * 8 + 4) = (f32x4){bflo(v.z), bfhi(v.z), bflo(v.w), bfhi(v.w)}; }
        const float a0r = sp[4096 + gn0], a0i = sp[6144 + gn0], a1r = sp[4096 + gn1], a1i = sp[6144 + gn1];
#pragma unroll 16
        for (int cc = 0; cc < c; ++cc) { const f32x2 e0 = E[cc * 64 + ql], e1 = E[cc * 64 + 32 + ql];
            float nr = a0r * h0r - a0i * h0i + e0.x, ni = a0r * h0i + a0i * h0r + e0.y; h0r = nr; h0i = ni;
            nr = a1r * h1r - a1i * h1i + e1.x; ni = a1r * h1i + a1i * h1r + e1.y; h1r = nr; h1i = ni; }
        const int cch = lane & 15, quad = lane >> 4;
#pragma unroll
        for (int s = 0; s < 4; ++s) { const float* cp = ((s < 2) ? p.c_re : p.c_im) + (((size_t)L * 32 + g) * 16 + cch) * 64 + 32 * (s & 1) + quad * 8; const float sg = (s < 2) ? 1.f : -1.f;
            const f32x4 x = *(const f32x4*)cp, y = *(const f32x4*)(cp + 4); u32x4 w; w.x = pk2(sg * x[0], sg * x[1]); w.y = pk2(sg * x[2], sg * x[3]); w.z = pk2(sg * y[0], sg * y[1]); w.w = pk2(sg * y[2], sg * y[3]);
            Cf[s] = __builtin_bit_cast(bf16x8, w); }
        dsk4 = *(const f32x4*)(p.s5_d + L * 512 + g * 16 + quad * 4);
        wave_sync();
    }
    bf16_t* YS = (bf16_t*)(p.ws + OFF_R2);
    bf16x8 ufa[4];
#pragma unroll
    for (int tb = 0; tb < 4; ++tb) ufa[tb] = *(const bf16x8*)(Zu + (size_t)(tb * 32 + ql) * ZW + 8 * hh);
#pragma unroll
    for (int tb = 0; tb < 4; ++tb) {
        const bf16x8 uf = ufa[tb];
        f32x16 Bu[4];
#pragma unroll
        for (int ct = 0; ct < 4; ++ct) Bu[ct] = MFMA32(uf, Bf[ct], zero16());
#pragma unroll
        for (int k = 0; k < 4; ++k) {
#pragma unroll
            for (int half = 0; half < 2; ++half) {
                if (hh == half) {
#pragma unroll
                    for (int r = 4 * k; r < 4 * k + 4; ++r) {
                        float nr = ar0 * h0r - ai0 * h0i + Bu[0][r], ni = ar0 * h0i + ai0 * h0r + Bu[2][r]; h0r = nr; h0i = ni; Bu[0][r] = nr; Bu[2][r] = ni;
                        nr = ar1 * h1r - ai1 * h1i + Bu[1][r]; ni = ar1 * h1i + ai1 * h1r + Bu[3][r]; h1r = nr; h1i = ni; Bu[1][r] = nr; Bu[3][r] = ni; }
                }
                const float x0 = __shfl_xor(h0r, 32), x1 = __shfl_xor(h0i, 32), x2 = __shfl_xor(h1r, 32), x3 = __shfl_xor(h1i, 32);
                if (hh != half) { h0r = x0; h0i = x1; h1r = x2; h1i = x3; }
            }
        }
        if (out) {
#pragma unroll
            for (int i = 0; i < 16; ++i) { const int tl = crow(i, hh); bf16_t* hp = Hs + tl * 136 + ql;
                hp[0] = f2bf(Bu[0][i]); hp[32] = f2bf(Bu[1][i]); hp[64] = f2bf(Bu[2][i]); hp[96] = f2bf(Bu[3][i]); }
            wave_sync();
            const int cch = lane & 15, quad = lane >> 4;
#pragma unroll
            for (int rt = 0; rt < 2; ++rt) { f32x4 acc = {0.f, 0.f, 0.f, 0.f};
#pragma unroll
                for (int s = 0; s < 4; ++s) { const bf16x8 av = *(const bf16x8*)(Hs + (rt * 16 + cch) * 136 + 32 * s + quad * 8); acc = MFMA16(Cf[s], av, acc); }
                const int t = tb * 32 + rt * 16 + cch; const f32x4 u4 = *(const f32x4*)(us + t * 16 + quad * 4);
                const float y0 = gelu_tanh(acc[0] + dsk4[0] * u4[0]), y1 = gelu_tanh(acc[1] + dsk4[1] * u4[1]), y2 = gelu_tanh(acc[2] + dsk4[2] * u4[2]), y3 = gelu_tanh(acc[3] + dsk4[3] * u4[3]);
                u32x2 w; w.x = pk2(y0, y1); w.y = pk2(y2, y3); *(u32x2*)(YS + (size_t)(c * 128 + t) * 512 + g * 16 + quad * 4) = w; }
            wave_sync();
        }
    }
    if (!out && hh == 0) { E[c * 64 + ql] = (f32x2){h0r, h0i}; E[c * 64 + 32 + ql] = (f32x2){h1r, h1i}; }
}
DI void s5_phase(const P& p, int L, unsigned char* lds, bool out) {
    const int wid = tidx() >> 6; unsigned char* wl = lds + wid * 16896;
    if (gridDim.x == 256) {
        const int slot = bidx() * 8 + wid, g = slot >> 6, cb = slot & 63;
        s5_wave(p, L, wl, g, cb, out);
        if (out || cb != 0) s5_wave(p, L, wl, g, 127 - cb, out);
    } else {
        const int nchunk = out ? 128 : 127;
        for (int it = bidx() * 8 + wid; it < 32 * nchunk; it += gridDim.x * 8) s5_wave(p, L, wl, it / nchunk, it % nchunk, out);
    }
}

DI void ret_load_T(const bf16_t* src, bf16_t* dst, int h, float lg, bool zeta) {
    const int tid = tidx();
#pragma unroll
    for (int it = 0; it < 4; ++it) { const int e = tid + 512 * it, m = e & 127, d8 = (e >> 7) * 8; const u32x4 v = *(const u32x4*)(src + (size_t)m * ZW + h * 128 + d8);
        const float z = zeta ? exp2f((float)(127 - m) * lg) : 1.f;
        const float f[8] = {bflo(v.x), bfhi(v.x), bflo(v.y), bfhi(v.y), bflo(v.z), bfhi(v.z), bflo(v.w), bfhi(v.w)};
#pragma unroll
        for (int j = 0; j < 8; ++j) dst[(d8 + j) * 136 + m] = f2bf(f[j] * z); }
}
DI void ret_pass1(const P& p, unsigned char* lds, int c, int h) {
    bf16_t* Kt = (bf16_t*)lds; bf16_t* Vt = Kt + 128 * 136;
    const bf16_t* Zm = (const bf16_t*)(p.ws + OFF_ZM) + (size_t)(c * 128) * ZW;
    const float lg = LG2G[h];
    ret_load_T(Zm + ZC_RK, Kt, h, lg, true); ret_load_T(Zm + ZC_RV, Vt, h, lg, false);
    __syncthreads();
    const int w = tidx() >> 6, lane = tidx() & 63, ql = lane & 31, hh = lane >> 5, et = w >> 1, dh2 = w & 1;
    f32x16 acc[2] = {zero16(), zero16()};
#pragma unroll
    for (int s = 0; s < 8; ++s) { const bf16x8 a = *(const bf16x8*)(Vt + (32 * et + ql) * 136 + 16 * s + 8 * hh);
#pragma unroll
        for (int dt = 0; dt < 2; ++dt) { const bf16x8 b = *(const bf16x8*)(Kt + (64 * dh2 + 32 * dt + ql) * 136 + 16 * s + 8 * hh); acc[dt] = MFMA32(a, b, acc[dt]); } }
    float* out = (float*)(p.ws + OFF_KVT) + (size_t)(c * 4 + h) * 16384;
#pragma unroll
    for (int dt = 0; dt < 2; ++dt)
#pragma unroll
        for (int i = 0; i < 16; ++i) out[(32 * et + crow(i, hh)) * 128 + 64 * dh2 + 32 * dt + ql] = acc[dt][i];
    __syncthreads();
}
DI void ret_prefix(const P& p, int item) {
    const int idx4 = item * 512 + tidx(), h = idx4 >> 12; const float gC = exp2f(128.f * LG2G[h]);
    const f32x4* kv = (const f32x4*)(p.ws + OFF_KVT) + idx4; u32x2* st = (u32x2*)(p.ws + OFF_STT) + idx4;
    f32x4 s = {0.f, 0.f, 0.f, 0.f};
#pragma unroll 16
    for (int c = 0; c < 128; ++c) { u32x2 w; w.x = pk2(s[0], s[1]); w.y = pk2(s[2], s[3]); st[(size_t)c * 16384] = w; if (c < 127) s = s * gC + kv[(size_t)c * 16384]; }
}
DI void ret_pass3(const P& p, unsigned char* lds, int c, int h) {
    bf16_t* Vt = (bf16_t*)lds; float* Yf = (float*)(lds + 34816);
    const bf16_t* Zm = (const bf16_t*)(p.ws + OFF_ZM) + (size_t)(c * 128) * ZW;
    const float lg = LG2G[h];
    ret_load_T(Zm + ZC_RV, Vt, h, lg, false);
    __syncthreads();
    const int w = tidx() >> 6, lane = tidx() & 63, ql = lane & 31, hh = lane >> 5, nt = w >> 1, eh = w & 1, n0 = 32 * nt, e0 = 64 * eh;
    bf16x8 qf[8];
#pragma unroll
    for (int s = 0; s < 8; ++s) qf[s] = *(const bf16x8*)(Zm + (size_t)(n0 + ql) * ZW + ZC_RQ + h * 128 + 16 * s + 8 * hh);
    f32x16 o[2] = {zero16(), zero16()}, cr[2] = {zero16(), zero16()};
    for (int mt = 0; mt <= nt; ++mt) {
        f32x16 sa = zero16();
#pragma unroll
        for (int s = 0; s < 8; ++s) { const bf16x8 kf = *(const bf16x8*)(Zm + (size_t)(32 * mt + ql) * ZW + ZC_RK + h * 128 + 16 * s + 8 * hh); sa = MFMA32(kf, qf[s], sa); }
        const int n = n0 + ql;
#pragma unroll
        for (int i = 0; i < 16; ++i) { const int m = 32 * mt + crow(i, hh); sa[i] = (n >= m) ? sa[i] * exp2f((float)(n - m) * lg) : 0.f; }
        const bf16x8 pb0 = pack8(sa, 0), pb1 = pack8(sa, 1);
#pragma unroll
        for (int et = 0; et < 2; ++et) { const bf16_t* vp = Vt + (e0 + 32 * et + ql) * 136 + 32 * mt + 4 * hh;
            o[et] = MFMA32(cat4(*(const s16x4*)vp, *(const s16x4*)(vp + 8)), pb0, o[et]);
            o[et] = MFMA32(cat4(*(const s16x4*)(vp + 16), *(const s16x4*)(vp + 24)), pb1, o[et]); }
    }
    const bf16_t* st = (const bf16_t*)(p.ws + OFF_STT) + (size_t)(c * 4 + h) * 16384;
#pragma unroll
    for (int s = 0; s < 8; ++s)
#pragma unroll
        for (int et = 0; et < 2; ++et) { const bf16x8 a = *(const bf16x8*)(st + (e0 + 32 * et + ql) * 128 + 16 * s + 8 * hh); cr[et] = MFMA32(a, qf[s], cr[et]); }
    const float xi = exp2f((float)(n0 + ql + 1) * lg);
#pragma unroll
    for (int et = 0; et < 2; ++et)
#pragma unroll
        for (int i = 0; i < 16; ++i) Yf[(n0 + ql) * 129 + e0 + 32 * et + crow(i, hh)] = o[et][i] + xi * cr[et][i];
    __syncthreads();
    { const int n = tidx() >> 2, part = tidx() & 3; const float* yp = Yf + n * 129 + part * 32; float ss = 0.f;
#pragma unroll
      for (int e = 0; e < 32; ++e) ss += yp[e] * yp[e];
      ss += __shfl_xor(ss, 1); ss += __shfl_xor(ss, 2);
      const float rs = rsqrtf(ss * (1.f / 128.f) + 1e-6f);
      const bf16_t* gp = Zm + (size_t)n * ZW + ZC_RG + h * 128 + part * 32; bf16_t* op = (bf16_t*)(p.ws + OFF_O4) + (size_t)(c * 128 + n) * 2048 + 1536 + h * 128 + part * 32;
#pragma unroll
      for (int e8 = 0; e8 < 4; ++e8) { const u32x4 gv = *(const u32x4*)(gp + e8 * 8); const float gf[8] = {bflo(gv.x), bfhi(gv.x), bflo(gv.y), bfhi(gv.y), bflo(gv.z), bfhi(gv.z), bflo(gv.w), bfhi(gv.w)}; float r[8];
#pragma unroll
          for (int j = 0; j < 8; ++j) r[j] = gf[j] * sigmoidf_(gf[j]) * yp[e8 * 8 + j] * rs;
          u32x4 w; w.x = pk2(r[0], r[1]); w.y = pk2(r[2], r[3]); w.z = pk2(r[4], r[5]); w.w = pk2(r[6], r[7]); *(u32x4*)(op + e8 * 8) = w; } }
    __syncthreads();
}

struct AttSt { f32x16 o[2]; float m2, l; };
struct KVStage { u32x4 k, v; };
constexpr int KVB_K = 0, KVB_V = 9216, KVB_SZ = 17920;
constexpr int NSA_SEL = 64 * 257 * 4, NSA_UM = NSA_SEL + 2048, NSA_KVB = NSA_UM + 128;
constexpr float SC2 = 0.125f * 1.4426950408889634f;
DI void kv_issue(KVStage& r, const bf16_t* K, size_t ldk, const bf16_t* Vt, size_t ldv, int kb, int tid) {
    const int row = tid >> 3, ch = tid & 7;
    r.k = *(const u32x4*)(K + (size_t)(kb + row) * ldk + ch * 8);
    r.v = *(const u32x4*)(Vt + (size_t)row * ldv + kb + ch * 8);
}
DI void kv_commit(const KVStage& r, unsigned char* buf, int tid) {
    const int row = tid >> 3, ch = tid & 7;
    *(u32x4*)(buf + KVB_K + row * 144 + ch * 16) = r.k;
    unsigned char* vp = buf + KVB_V + row * 136 + ch * 16;
    *(u32x2*)vp = (u32x2){r.v.x, r.v.y}; *(u32x2*)(vp + 8) = (u32x2){r.v.z, r.v.w};
}
DI int slc_next(const unsigned* um, int j, int qt) { for (++j; j <= qt; ++j) if ((um[j >> 5] >> (j & 31)) & 1u) return j; return -1; }
DI float fexp2(float x) { return __builtin_amdgcn_exp2f(x); }

template <int MODE>
DI void nsa_tile(const unsigned char* buf, const bf16x8 (&qf)[4], AttSt& a, int kb, int t, int tq0, int qt, int cur, unsigned bit, float Mfix, float inv, unsigned* imp, int qrow, int ql, int hh) {
    if (MODE == 2 && __ballot(bit) == 0ull) return;
    f32x16 sa[2];
#pragma unroll
    for (int u = 0; u < 2; ++u) { const unsigned char* kp = buf + KVB_K + (u * 32 + ql) * 144 + hh * 16; sa[u] = zero16();
#pragma unroll
        for (int s = 0; s < 4; ++s) sa[u] = MFMA32(*(const bf16x8*)(kp + 32 * s), qf[s], sa[u]); }
    if (MODE == 0) {
        float mx = -1e30f;
#pragma unroll
        for (int u = 0; u < 2; ++u)
#pragma unroll
            for (int i = 0; i < 16; ++i) { const int n = kb + u * 32 + crow(i, hh); sa[u][i] = (16 * n + 31 <= t) ? sa[u][i] * SC2 : -1e30f; mx = fmaxf(mx, sa[u][i]); }
        const float mn = fmaxf(a.m2, mx); float ls = 0.f;
#pragma unroll
        for (int u = 0; u < 2; ++u)
#pragma unroll
            for (int i = 0; i < 16; ++i) ls += (sa[u][i] > -1e29f) ? fexp2(sa[u][i] - mn) : 0.f;
        a.l = a.l * fexp2(a.m2 - mn) + ls; a.m2 = mn;
        return;
    }
    if (MODE == 1) {
#pragma unroll
        for (int u = 0; u < 2; ++u) {
#pragma unroll
            for (int i = 0; i < 16; ++i) { const int n = kb + u * 32 + crow(i, hh); sa[u][i] = (16 * n + 31 <= t) ? fexp2(sa[u][i] * SC2 - Mfix) * inv : 0.f; }
#pragma unroll
            for (int gi = 0; gi < 4; ++gi) { const float a4 = (sa[u][4 * gi] + sa[u][4 * gi + 1]) + (sa[u][4 * gi + 2] + sa[u][4 * gi + 3]); const int j = (kb >> 2) + 8 * u + 2 * gi + hh;
                const unsigned ua = (unsigned)(a4 * 67108864.f), ub = (unsigned)(sa[u][4 * gi + 3] * 67108864.f);
                if (ua) atomicAdd(&imp[qrow * 257 + j], ua);
                if (ub && j + 1 < 256) atomicAdd(&imp[qrow * 257 + j + 1], ub); } }
    } else {
        bool need_mask;
        if (MODE == 2) need_mask = (cur == qt); else need_mask = (kb + 63 > tq0) || (kb < tq0 - 504);
        float mn;
        if (need_mask) {
            float mx = -1e30f; unsigned vm = 0u;
#pragma unroll
            for (int u = 0; u < 2; ++u)
#pragma unroll
                for (int i = 0; i < 16; ++i) { const int key = kb + u * 32 + crow(i, hh); const bool vis = (MODE == 2) ? (bit && key <= t) : (key <= t && key > t - 512);
                    sa[u][i] = vis ? sa[u][i] * SC2 : -1e30f; mx = fmaxf(mx, sa[u][i]); }
            (void)vm;
            mx = fmaxf(mx, __shfl_xor(mx, 32)); mn = fmaxf(a.m2, mx);
#pragma unroll
            for (int u = 0; u < 2; ++u)
#pragma unroll
                for (int i = 0; i < 16; ++i) sa[u][i] = (sa[u][i] > -1e29f) ? fexp2(sa[u][i] - mn) : 0.f;
        } else {
            float mx = -1e30f;
#pragma unroll
            for (int u = 0; u < 2; ++u)
#pragma unroll
                for (int i = 0; i < 16; ++i) mx = fmaxf(mx, sa[u][i]);
            mx *= SC2;
            if (MODE == 2 && !bit) mx = -1e30f;
            mx = fmaxf(mx, __shfl_xor(mx, 32)); mn = fmaxf(a.m2, mx);
            const float mref = (MODE == 2 && !bit) ? 1e30f : mn;
#pragma unroll
            for (int u = 0; u < 2; ++u)
#pragma unroll
                for (int i = 0; i < 16; ++i) sa[u][i] = fexp2(__builtin_fmaf(sa[u][i], SC2, -mref));
        }
        if (__ballot(mn > a.m2) != 0ull) { const float al = fexp2(a.m2 - mn); a.l *= al;
#pragma unroll
            for (int i = 0; i < 16; ++i) { a.o[0][i] *= al; a.o[1][i] *= al; } }
        a.m2 = mn; float ls = 0.f;
#pragma unroll
        for (int u = 0; u < 2; ++u)
#pragma unroll
            for (int i = 0; i < 16; ++i) ls += sa[u][i];
        a.l += ls;
    }
#pragma unroll
    for (int u = 0; u < 2; ++u) { const bf16x8 pb0 = pack8(sa[u], 0), pb1 = pack8(sa[u], 1);
#pragma unroll
        for (int dt = 0; dt < 2; ++dt) { const unsigned char* vp = buf + KVB_V + (32 * dt + ql) * 136 + (u * 32 + 4 * hh) * 2;
            a.o[dt] = MFMA32(cat4(*(const s16x4*)vp, *(const s16x4*)(vp + 16)), pb0, a.o[dt]);
            a.o[dt] = MFMA32(cat4(*(const s16x4*)(vp + 32), *(const s16x4*)(vp + 48)), pb1, a.o[dt]); } }
}
template <int MODE>
DI void nsa_branch(unsigned char* lds, const bf16_t* K, size_t ldk, const bf16_t* Vt, size_t ldv, const bf16x8 (&qf)[4], AttSt& a, int t, int tq0, int qt, float Mfix, float inv, int qrow, int tid, int ql, int hh) {
    unsigned* imp = (unsigned*)lds; const unsigned* sel = (const unsigned*)(lds + NSA_SEL); const unsigned* um = (const unsigned*)(lds + NSA_UM); unsigned char* kvb = lds + NSA_KVB;
    const int q0 = qt * 64;
    const int ntc = ((4 * qt + 2) >> 6) + 1, kb0w = (q0 >= 512) ? q0 - 512 : 0, ntw = ((q0 - kb0w) >> 6) + 1;
    int cur = 0, bsel = 0;
    KVStage st;
    kv_issue(st, K, ldk, Vt, ldv, (MODE == 3) ? kb0w : 0, tid); kv_commit(st, kvb, tid);
    __syncthreads();
    while (cur >= 0) {
        int nxt;
        if (MODE == 2) nxt = slc_next(um, cur, qt); else nxt = (cur + 1 < ((MODE == 3) ? ntw : ntc)) ? cur + 1 : -1;
        const int kbn = (MODE == 3) ? kb0w + 64 * nxt : 64 * nxt;
        if (nxt >= 0) kv_issue(st, K, ldk, Vt, ldv, kbn, tid);
        const int kb = (MODE == 3) ? kb0w + 64 * cur : 64 * cur;
        unsigned bit = 1u;
        if (MODE == 2) bit = (sel[qrow * 8 + (cur >> 5)] >> (cur & 31)) & 1u;
        nsa_tile<MODE>(kvb + bsel * KVB_SZ, qf, a, kb, t, tq0, qt, cur, bit, Mfix, inv, imp, qrow, ql, hh);
        if (nxt >= 0) kv_commit(st, kvb + (bsel ^ 1) * KVB_SZ, tid);
        __syncthreads();
        bsel ^= 1; cur = nxt;
    }
}
DI void nsa_branch_slc2(unsigned char* lds, const bf16_t* K, size_t ldk, const bf16_t* Vt, size_t ldv, const bf16x8 (&qf)[4], AttSt& a, int t, int tq0, int qt, int qrow, int tid, int ql, int hh) {
    unsigned* imp = (unsigned*)lds; const unsigned* sel = (const unsigned*)(lds + NSA_SEL); const unsigned* um = (const unsigned*)(lds + NSA_UM); unsigned char* kvb = lds + NSA_KVB;
    int c0 = 0, c1 = slc_next(um, 0, qt), bsel = 0;
    KVStage s0, s1;
    kv_issue(s0, K, ldk, Vt, ldv, 0, tid); if (c1 >= 0) kv_issue(s1, K, ldk, Vt, ldv, 64 * c1, tid);
    kv_commit(s0, kvb, tid); if (c1 >= 0) kv_commit(s1, kvb + KVB_SZ, tid);
    __syncthreads();
    while (c0 >= 0) {
        const int n0 = (c1 >= 0) ? slc_next(um, c1, qt) : -1, n1 = (n0 >= 0) ? slc_next(um, n0, qt) : -1;
        if (n0 >= 0) kv_issue(s0, K, ldk, Vt, ldv, 64 * n0, tid);
        if (n1 >= 0) kv_issue(s1, K, ldk, Vt, ldv, 64 * n1, tid);
        unsigned char* cb = kvb + bsel * 2 * KVB_SZ;
        { const unsigned bit = (sel[qrow * 8 + (c0 >> 5)] >> (c0 & 31)) & 1u; nsa_tile<2>(cb, qf, a, 64 * c0, t, tq0, qt, c0, bit, 0.f, 0.f, imp, qrow, ql, hh); }
        if (c1 >= 0) { const unsigned bit = (sel[qrow * 8 + (c1 >> 5)] >> (c1 & 31)) & 1u; nsa_tile<2>(cb + KVB_SZ, qf, a, 64 * c1, t, tq0, qt, c1, bit, 0.f, 0.f, imp, qrow, ql, hh); }
        unsigned char* nb = kvb + (bsel ^ 1) * 2 * KVB_SZ;
        if (n0 >= 0) kv_commit(s0, nb, tid);
        if (n1 >= 0) kv_commit(s1, nb + KVB_SZ, tid);
        __syncthreads();
        bsel ^= 1; c0 = n0; c1 = n1;
    }
}
DI void nsa_item(const P& p, unsigned char* lds, int g, int qt) {
    const int tid = tidx(), wid = tid >> 6, lane = tid & 63, ql = lane & 31, hh = lane >> 5;
    const int hd = g * 4 + (ql & 3), tq0 = qt * 64 + wid * 8, t = tq0 + (ql >> 2), qrow = wid * 8 + (ql >> 2);
    unsigned* imp = (unsigned*)lds; unsigned* sel = (unsigned*)(lds + NSA_SEL); unsigned* um = (unsigned*)(lds + NSA_UM);
    for (int i = tid; i < 64 * 257; i += 512) imp[i] = 0u;
    const bf16_t* Zm = (const bf16_t*)(p.ws + OFF_ZM);
    bf16x8 qf[4];
#pragma unroll
    for (int s = 0; s < 4; ++s) qf[s] = *(const bf16x8*)(Zm + (size_t)t * ZW + ZC_Q + hd * 64 + 16 * s + 8 * hh);
    const bf16_t* gp = Zm + (size_t)t * ZW + ZC_NG + hd;
    const float g_cmp = bf2f(gp[0]), g_slc = bf2f(gp[8]), g_win = bf2f(gp[16]);
    f32x16 ot[2];
    {
        const bf16_t* kc = (const bf16_t*)(p.ws + OFF_KC) + (size_t)g * 1024 * 64; const bf16_t* vct = (const bf16_t*)(p.ws + OFF_VCT) + (size_t)g * 64 * 1024;
        AttSt a; a.o[0] = zero16(); a.o[1] = zero16(); a.m2 = -1e30f; a.l = 0.f;
        nsa_branch<0>(lds, kc, 64, vct, 1024, qf, a, t, tq0, qt, 0.f, 0.f, qrow, tid, ql, hh);
        const float mo = __shfl_xor(a.m2, 32), lo = __shfl_xor(a.l, 32), M = fmaxf(a.m2, mo), Lt = a.l * fexp2(a.m2 - M) + lo * fexp2(mo - M);
        const float inv = (Lt > 0.f) ? 1.f / Lt : 0.f;
        nsa_branch<1>(lds, kc, 64, vct, 1024, qf, a, t, tq0, qt, M, inv, qrow, tid, ql, hh);
#pragma unroll
        for (int i = 0; i < 16; ++i) { ot[0][i] = g_cmp * a.o[0][i]; ot[1][i] = g_cmp * a.o[1][i]; }
    }
    for (int qi = 0; qi < 8; ++qi) {
        const int q = wid * 8 + qi; unsigned key[4]; bool pick[4];
#pragma unroll
        for (int i = 0; i < 4; ++i) { const int j = lane + 64 * i; key[i] = (j >= 1 && j <= qt - 1) ? imp[q * 257 + j] + 1u : 0u; }
        if (qt < 16) {
#pragma unroll
            for (int i = 0; i < 4; ++i) pick[i] = (lane + 64 * i) <= qt;
        } else {
            unsigned T = 0u;
            for (int b = 31; b >= 0; --b) { const unsigned T2 = T | (1u << b); int cnt = 0;
#pragma unroll
                for (int i = 0; i < 4; ++i) cnt += __popcll(__ballot(key[i] >= T2));
                if (cnt >= 14) T = T2; }
            int ngt = 0;
#pragma unroll
            for (int i = 0; i < 4; ++i) ngt += __popcll(__ballot(key[i] > T));
            int need = 14 - ngt, base = 0;
#pragma unroll
            for (int i = 0; i < 4; ++i) { const unsigned long long eq = __ballot(key[i] == T); const int pre = base + __popcll(eq & ((1ull << lane) - 1ull));
                const int j = lane + 64 * i; pick[i] = (key[i] > T) || (key[i] == T && pre < need) || j == 0 || j == qt; base += __popcll(eq); }
        }
#pragma unroll
        for (int i = 0; i < 4; ++i) { const unsigned long long mk = __ballot(pick[i]); if (lane == 0) { sel[q * 8 + 2 * i] = (unsigned)mk; sel[q * 8 + 2 * i + 1] = (unsigned)(mk >> 32); } }
    }
    __syncthreads();
    if (wid == 0) {
#pragma unroll
        for (int w = 0; w < 8; ++w) { unsigned x = sel[lane * 8 + w];
#pragma unroll
            for (int o = 32; o > 0; o >>= 1) x |= __shfl_xor(x, o);
            if (lane == 0) um[w] = x; }
    }
    __syncthreads();
    {
        const bf16_t* Ks = Zm + ZC_KV + 2 * 128 + g * 64; const bf16_t* Vts = (const bf16_t*)(p.ws + OFF_VT) + (size_t)(0 * 2 + g) * 64 * S;
        AttSt a; a.o[0] = zero16(); a.o[1] = zero16(); a.m2 = -1e30f; a.l = 0.f;
        nsa_branch_slc2(lds, Ks, ZW, Vts, S, qf, a, t, tq0, qt, qrow, tid, ql, hh);
        const float Lt = a.l + __shfl_xor(a.l, 32), sc = (Lt > 0.f) ? g_slc / Lt : 0.f;
#pragma unroll
        for (int i = 0; i < 16; ++i) { ot[0][i] += sc * a.o[0][i]; ot[1][i] += sc * a.o[1][i]; }
    }
    {
        const bf16_t* Kw = Zm + ZC_KV + 4 * 128 + g * 64; const bf16_t* Vtw = (const bf16_t*)(p.ws + OFF_VT) + (size_t)(1 * 2 + g) * 64 * S;
        AttSt a; a.o[0] = zero16(); a.o[1] = zero16(); a.m2 = -1e30f; a.l = 0.f;
        nsa_branch<3>(lds, Kw, ZW, Vtw, S, qf, a, t, tq0, qt, 0.f, 0.f, qrow, tid, ql, hh);
        const float Lt = a.l + __shfl_xor(a.l, 32), sc = (Lt > 0.f) ? g_win / Lt : 0.f;
#pragma unroll
        for (int i = 0; i < 16; ++i) { ot[0][i] += sc * a.o[0][i]; ot[1][i] += sc * a.o[1][i]; }
    }
    bf16_t* op = (bf16_t*)(p.ws + OFF_O4) + (size_t)t * 2048 + hd * 64 + 4 * hh;
#pragma unroll
    for (int dt = 0; dt < 2; ++dt)
#pragma unroll
        for (int gi = 0; gi < 4; ++gi) { u32x2 w; w.x = pk2(ot[dt][4 * gi], ot[dt][4 * gi + 1]); w.y = pk2(ot[dt][4 * gi + 2], ot[dt][4 * gi + 3]); *(u32x2*)(op + 32 * dt + 8 * gi) = w; }
    __syncthreads();
}


#define XB_TMO      128
#define XB_XCNT(j)  (256  + 64 * (j))
#define XB_XSUB(j)  (1280 + 64 * (j))
#define XB_XGEN(j)  (2304 + 64 * (j))
#define XB_TOP      3328
#define XB_TOPGEN   3392
#define XCD_BAR_WORDS 3456
#define XB_SPIN_CAP (1u << 18)
DI unsigned xb_ld(unsigned* p)              { return __hip_atomic_load(p, __ATOMIC_RELAXED, __HIP_MEMORY_SCOPE_AGENT); }
DI unsigned xb_add(unsigned* p, unsigned v) { return __hip_atomic_fetch_add(p, v, __ATOMIC_RELAXED, __HIP_MEMORY_SCOPE_AGENT); }
DI unsigned xb_xcc_id() { return (unsigned)__builtin_amdgcn_s_getreg((3 << 11) | 20) & 0xFu; }
#define XB_SPIN(cond, bar) do { unsigned _sp = 0; while (cond) { __builtin_amdgcn_s_sleep(1); \
    if ((++_sp & 255u) == 0u) { if (xb_ld(&(bar)[XB_TMO])) break; if (_sp > XB_SPIN_CAP) { atomicAdd(&(bar)[XB_TMO], 1u); break; } } } } while (0)
struct XcdBarrier { unsigned* bar; unsigned x; volatile LAS unsigned* st; };
DI XcdBarrier xcd_barrier_post(unsigned* bar, volatile LAS unsigned* st) {
    XcdBarrier b; b.bar = bar; b.x = xb_xcc_id(); b.st = st;
    if (threadIdx.x == 0) (void)xb_add(&bar[XB_XCNT(b.x)], 1u);
    return b;
}
DI void xcd_barrier_complete(unsigned* bar, unsigned x, unsigned& nloc, unsigned& nx) {
    const unsigned G = gridDim.x * gridDim.y * gridDim.z;
    unsigned sum, cnt, mine, sp = 0u;
    for (;;) {
        sum = 0u; cnt = 0u; mine = 0u;
#pragma unroll
        for (unsigned j = 0; j < 16; ++j) { const unsigned c = xb_ld(&bar[XB_XCNT(j)]); sum += c; cnt += (c > 0u) ? 1u : 0u; mine = (j == x) ? c : mine; }
        if (sum == G) break;
        __builtin_amdgcn_s_sleep(1);
        if ((++sp & 255u) == 0u) { if (xb_ld(&bar[XB_TMO])) break; if (sp > XB_SPIN_CAP) { atomicAdd(&bar[XB_TMO], 1u); break; } }
    }
    nloc = mine > 0u ? mine : 1u; nx = cnt > 0u ? cnt : 1u;
}
DI void xcd_barrier(const XcdBarrier& b) {
    asm volatile("s_waitcnt vmcnt(0)" ::: "memory");
    __syncthreads();
    if (threadIdx.x == 0) {
        unsigned* bar = b.bar;
        __builtin_amdgcn_s_waitcnt(0);
        unsigned nloc = b.st[0], nx = b.st[1];
        if (nloc == 0u) { xcd_barrier_complete(bar, b.x, nloc, nx); b.st[0] = nloc; b.st[1] = nx; }
        const unsigned old = xb_add(&bar[XB_XSUB(b.x)], 1u);
        const unsigned gen = old / nloc;
        if (old + 1u == (gen + 1u) * nloc) {
            __builtin_amdgcn_fence(__ATOMIC_RELEASE, "agent");
            asm volatile("s_waitcnt vmcnt(0)" ::: "memory");
            const unsigned og = xb_add(&bar[XB_TOP], 1u);
            const unsigned tg = og / nx;
            if (og + 1u == (tg + 1u) * nx) xb_add(&bar[XB_TOPGEN], 1u);
            else XB_SPIN(xb_ld(&bar[XB_TOPGEN]) == tg, bar);
            __builtin_amdgcn_fence(__ATOMIC_ACQUIRE, "agent");
            xb_add(&bar[XB_XGEN(b.x)], 1u);
            asm volatile("s_waitcnt vmcnt(0)" ::: "memory");
        } else {
            XB_SPIN(xb_ld(&bar[XB_XGEN(b.x)]) == gen, bar);
            __builtin_amdgcn_fence(__ATOMIC_ACQUIRE, "agent");
            asm volatile("s_waitcnt vmcnt(0)" ::: "memory");
        }
    }
    __syncthreads();
}
#ifndef REP_BR
#define REP_BR 1
#endif
#ifndef REP_S5
#define REP_S5 1
#endif
#ifndef REP_NSA
#define REP_NSA 1
#endif
#ifndef REP_CONV
#define REP_CONV 1
#endif
#ifndef REP_MISC
#define REP_MISC 1
#endif
#ifndef REP_GEMM
#define REP_GEMM 1
#endif
__global__ void __launch_bounds__(512) fwd_megakernel(P p) {
    extern __shared__ __attribute__((aligned(16))) unsigned char lds[];
    cg::grid_group grid = cg::this_grid();
    LAS unsigned char* l3 = (LAS unsigned char*)lds;
    const int G = gridDim.x;
    unsigned char* ws = p.ws;
    bf16_t* Xb = (bf16_t*)(ws + OFF_XB);
    bf16_t* VN = (bf16_t*)(ws + OFF_O4);
    float* SS = (float*)(ws + OFF_SS);
    volatile LAS unsigned* bst = (volatile LAS unsigned*)(l3 + LDS_BYTES - 16);
    if (threadIdx.x < 2) bst[threadIdx.x] = 0u;
    __syncthreads();
    const XcdBarrier xb = xcd_barrier_post((unsigned*)(ws + OFF_BAR), bst);
    int c = 0;
#pragma unroll 1
    for (int L = 0; L < 2; ++L) {
        c = bidx();
        for (int rep = 0; rep < REP_CONV; ++rep) conv_phase(p, L, lds);
        misc_prep(p, L);
        if (L == 0) norm_phase<false, false>(p.x, nullptr, p.g_mix, Xb, nullptr);
        if (G == 0x7fffffff) grid.sync();
        xcd_barrier(xb);
        c = bidx();
        { pg8::Gemm g{L == 0 ? Xb : VN, (const bf16_t*)(ws + OFF_WIN), DM, DM}; pg8::StaticOrder so; so.init(64, 50, G, c);
          pg8::EpiIn e{(bf16_t*)(ws + OFF_ZM), ws + OFF_G8, (const f32x2*)(ws + OFF_TRIG), L == 0 ? nullptr : SS + 2 * S}; for (int rep = 0; rep < REP_GEMM; ++rep) pg8::gemm_phase(l3, g, so, e); }
        { pg8::Gemm g{(const bf16_t*)(ws + OFF_PBF), (const bf16_t*)(ws + OFF_WPP), 256, 256}; pg8::PpOrder so{G, c};
          pg8::EpiBf<0> e{(bf16_t*)(ws + OFF_PPB), DM, nullptr}; pg8::gemm_phase(l3, g, so, e); }
        xcd_barrier(xb);
        c = bidx();
        for (int rep = 0; rep < REP_MISC; ++rep) {
        compress_phase(p, lds);
        vt_pool_phase(p);
        __syncthreads();
        for (int r5 = 0; r5 < REP_S5; ++r5) { s5_phase(p, L, lds, false); __syncthreads(); }
        __syncthreads();
        for (int it = c; it < 127 * 4; it += G) ret_pass1(p, lds, it >> 2, it & 3);
        }
        xcd_barrier(xb);
        c = bidx();
        for (int rep = 0; rep < REP_NSA; ++rep) for (int it = c; it < 512; it += G) { const int g = it >> 8, qt = g ? 255 - (it & 255) : (it & 255); nsa_item(p, lds, g, qt); }
        __syncthreads();
        for (int rep = 0; rep < REP_MISC; ++rep) {
        for (int r5 = 0; r5 < REP_S5; ++r5) { s5_phase(p, L, lds, true); __syncthreads(); }
        __syncthreads();
        for (int it = c; it < 32; it += G) ret_prefix(p, it);
        }
        xcd_barrier(xb);
        c = bidx();
        for (int rep = 0; rep < REP_MISC; ++rep) for (int it = c; it < 512; it += G) ret_pass3(p, lds, it >> 2, it & 3);
        __syncthreads();
        { pg8::Gemm g{(const bf16_t*)(ws + OFF_R2), (const bf16_t*)(ws + OFF_WGP), 512, 512}; pg8::GpOrder so{G, c};
          pg8::EpiGp e{(bf16_t*)(ws + OFF_O4) + 512, (bf16_t*)(ws + OFF_O4) + 1024, p.pool_scale + L * 512}; pg8::gemm_phase(l3, g, so, e); }
        xcd_barrier(xb);
        c = bidx();
        { pg8::Gemm g{(const bf16_t*)(ws + OFF_O4), (const bf16_t*)(ws + OFF_WBR), DM, DM}; pg8::StaticOrder so; so.init(64, 8, G, c);
          pg8::EpiBr e{ws + OFF_G8, Xb}; for (int rep = 0; rep < REP_BR; ++rep) pg8::gemm_phase(l3, g, so, e); }
        xcd_barrier(xb);
        c = bidx();
        { pg8::Gemm g{Xb, (const bf16_t*)(ws + OFF_WOUT), DM, DM}; pg8::StaticOrder so; so.init(64, 8, G, c);
          pg8::EpiH<0> e{L == 0 ? p.x : p.h, p.h, nullptr, nullptr, VN, p.g_mlp + L * DM, SS + L * S}; pg8::gemm_phase(l3, g, so, e); }
        xcd_barrier(xb);
        c = bidx();
        { pg8::Gemm g{VN, (const bf16_t*)(ws + OFF_WUP), DM, DM}; pg8::StaticOrder so; so.init(64, 32, G, c);
          pg8::EpiBf<1> e{(bf16_t*)(ws + OFF_HID), DFF, SS + L * S}; for (int rep = 0; rep < REP_GEMM; ++rep) pg8::gemm_phase(l3, g, so, e); }
        xcd_barrier(xb);
        c = bidx();
        { pg8::Gemm g{(const bf16_t*)(ws + OFF_HID), (const bf16_t*)(ws + OFF_WDN), DFF, DFF}; pg8::StaticOrder so; so.init(64, 8, G, c);
          pg8::EpiH<1> e{p.h, p.h, Xb, nullptr, nullptr, nullptr, nullptr}; pg8::gemm_phase(l3, g, so, e); }
        xcd_barrier(xb);
        c = bidx();
        { pg8::Gemm g{Xb, (const bf16_t*)(ws + OFF_WPG), DM, DM}; pg8::StaticOrder so; so.init(64, 8, G, c);
          pg8::EpiH<2> e{p.h, p.h, nullptr, (const bf16_t*)(ws + OFF_PPB), L == 0 ? VN : nullptr, p.g_mix + DM, SS + 2 * S}; pg8::gemm_phase(l3, g, so, e); }
        xcd_barrier(xb);
    }
    norm_phase<false, true>(p.h, nullptr, p.g_final, nullptr, p.h);
}

extern "C" void kernel_launch(void* const* d_in, const int* in_sizes, int n_in, void* d_out, int out_size, void* d_ws, size_t ws_size, hipStream_t stream) {
    static int grid_blocks = 0;
    if (!grid_blocks) {
        if (ws_size < WS_END) { fprintf(stderr, "kernel_launch: workspace too small: %zu < %zu\n", ws_size, (size_t)WS_END); grid_blocks = -1; return; }
        int dev = 0, cus = 0, per_cu = 0;
        hipGetDevice(&dev);
        hipDeviceGetAttribute(&cus, hipDeviceAttributeMultiprocessorCount, dev);
        hipFuncSetAttribute((const void*)fwd_megakernel, hipFuncAttributeMaxDynamicSharedMemorySize, LDS_BYTES);
        hipOccupancyMaxActiveBlocksPerMultiprocessor(&per_cu, (const void*)fwd_megakernel, 512, LDS_BYTES);
        if (per_cu < 1) per_cu = 1;
        grid_blocks = cus * per_cu;
    }
    if (grid_blocks < 0) return;
    P p{};
    const float** f = (const float**)&p;
    for (int i = 0; i < 25; ++i) f[i] = (const float*)d_in[i];
    p.h = (float*)d_out; p.ws = (unsigned char*)d_ws;
    (void)hipMemsetAsync((unsigned char*)d_ws + OFF_BAR, 0, 16384 + 3 * 65536, stream);
    void* args[] = {&p};
    hipError_t e = hipLaunchCooperativeKernel((const void*)fwd_megakernel, dim3(grid_blocks), dim3(512), args, LDS_BYTES, stream);
    if (e != hipSuccess) fprintf(stderr, "cooperative launch failed: %s (grid %d)\n", hipGetErrorString(e), grid_blocks);
}
```

```cpp
#include <hip/hip_runtime.h>
#include <hip/hip_cooperative_groups.h>
#include <cstdio>
namespace cg = cooperative_groups;

#define DI __device__ __forceinline__
#define LAS __attribute__((address_space(3)))
typedef unsigned short bf16_t;
typedef short bf16x8 __attribute__((ext_vector_type(8)));
typedef short s16x4 __attribute__((ext_vector_type(4)));
typedef float f32x2 __attribute__((ext_vector_type(2)));
typedef float f32x4 __attribute__((ext_vector_type(4)));
typedef float f32x16 __attribute__((ext_vector_type(16)));
typedef unsigned u32x2 __attribute__((ext_vector_type(2)));
typedef unsigned u32x4 __attribute__((ext_vector_type(4)));
typedef __bf16 bf16v2 __attribute__((ext_vector_type(2)));

constexpr int S = 16384, DM = 2048, ZW = 4608, NIN = 12800, DFF = 8192;
constexpr int LDS_BYTES = 143360;

constexpr size_t OFF_WIN = 0;
constexpr size_t OFF_WUP = OFF_WIN + (size_t)NIN * DM * 2;
constexpr size_t OFF_WDN = OFF_WUP + (size_t)DFF * DM * 2;
constexpr size_t OFF_WOUT = OFF_WDN + (size_t)DFF * DM * 2;
constexpr size_t OFF_WPG = OFF_WOUT + (size_t)DM * DM * 2;
constexpr size_t OFF_WBR = OFF_WPG + (size_t)DM * DM * 2;
constexpr size_t OFF_WPP = OFF_WBR + (size_t)8192 * 512 * 2;
constexpr size_t OFF_WGP = OFF_WPP + (size_t)DM * 256 * 2;
constexpr size_t OFF_WCMP = OFF_WGP + (size_t)1536 * 512 * 2;
constexpr size_t OFF_PBF = OFF_WCMP + (size_t)128 * 2048 * 2;
constexpr size_t OFF_TRIG = OFF_PBF + (size_t)S * 256 * 2;
constexpr size_t OFF_S5P = OFF_TRIG + (size_t)S * 64 * 8;
constexpr size_t OFF_S5E = OFF_S5P + 294912;
constexpr size_t OFF_ZM = OFF_S5E + (size_t)32 * 128 * 64 * 8;
constexpr size_t OFF_G8 = OFF_ZM + (size_t)(S + 64) * ZW * 2;
constexpr size_t OFF_XB = OFF_G8 + (size_t)S * 8192;
constexpr size_t OFF_R2 = OFF_XB + (size_t)S * DM * 2;
constexpr size_t OFF_O4 = OFF_R2 + (size_t)S * DM * 2;
constexpr size_t OFF_KC = OFF_O4 + (size_t)4 * S * 512 * 2;
constexpr size_t OFF_VCT = OFF_KC + (size_t)2 * 1024 * 64 * 2;
constexpr size_t OFF_VT = OFF_VCT + (size_t)2 * 64 * 1024 * 2;
constexpr size_t OFF_KVT = OFF_VT + (size_t)4 * 64 * S * 2;
constexpr size_t OFF_STT = OFF_KVT + (size_t)128 * 65536 * 4;
constexpr size_t OFF_BAR = OFF_STT + (size_t)128 * 65536 * 2;
constexpr size_t OFF_SS = OFF_BAR + 16384;
constexpr size_t OFF_PPB = OFF_SS + 3 * 65536;
constexpr size_t WS_END = OFF_PPB + (size_t)S * DM * 2;
constexpr size_t OFF_HID = OFF_ZM;
static_assert((size_t)S * DFF * 2 <= OFF_XB - OFF_ZM, "hidden alias");

constexpr int ZC_Q = 0, ZC_KV = 512, ZC_S5 = 1280, ZC_POOL = 1792, ZC_RQ = 2304, ZC_RK = 2816, ZC_RV = 3328, ZC_RG = 3840, ZC_NG = 4352;

struct P {
    const float *x, *p, *g_mix, *w_in, *w_cmp_k, *w_cmp_v, *a_re, *a_im, *log_dt, *b_re, *b_im, *c_re, *c_im, *s5_d, *w_glu, *pool_w, *pool_scale,
        *w_branch, *w_out, *g_mlp, *w_up, *w_down, *w_pg, *w_pp, *g_final;
    float* h;
    unsigned char* ws;
};

DI unsigned pk2(float a, float b) { f32x2 v = {a, b}; bf16v2 r = __builtin_convertvector(v, bf16v2); return __builtin_bit_cast(unsigned, r); }
DI bf16_t f2bf(float a) { return (bf16_t)(pk2(a, 0.f) & 0xffffu); }
DI float bf2f(bf16_t x) { return __uint_as_float((unsigned)x << 16); }
DI float bflo(unsigned w) { return __uint_as_float(w << 16); }
DI float bfhi(unsigned w) { return __uint_as_float(w & 0xffff0000u); }
DI float sigmoidf_(float x) { return __builtin_amdgcn_rcpf(1.f + __builtin_amdgcn_exp2f(-1.4426950408889634f * x)); }
DI float gelu_tanh(float x) { float z = 0.7978845608f * (x + 0.044715f * x * x * x); float e = __expf(2.f * z); float th = 1.f - 2.f / (e + 1.f); return 0.5f * x * (1.f + th); }
DI int tidx() { int t = threadIdx.x; asm volatile("" : "+v"(t)); return t; }
DI int bidx() { int b = blockIdx.x; asm volatile("" : "+s"(b)); return b; }
DI int crow(int i, int h) { return (i & 3) + 8 * (i >> 2) + 4 * h; }
DI void wave_sync() { asm volatile("s_waitcnt lgkmcnt(0)" ::: "memory"); __builtin_amdgcn_wave_barrier(); asm volatile("" ::: "memory"); }
#define MFMA32(a, b, c) __builtin_amdgcn_mfma_f32_32x32x16_bf16((a), (b), (c), 0, 0, 0)
#define MFMA16(a, b, c) __builtin_amdgcn_mfma_f32_16x16x32_bf16((a), (b), (c), 0, 0, 0)
DI f32x16 zero16() { f32x16 z; for (int i = 0; i < 16; ++i) z[i] = 0.f; return z; }
DI bf16x8 pack8(const f32x16& x, int s) {
    u32x4 w; w.x = pk2(x[8 * s], x[8 * s + 1]); w.y = pk2(x[8 * s + 2], x[8 * s + 3]); w.z = pk2(x[8 * s + 4], x[8 * s + 5]); w.w = pk2(x[8 * s + 6], x[8 * s + 7]);
    return __builtin_bit_cast(bf16x8, w);
}
DI bf16x8 cat4(s16x4 a, s16x4 b) { return __builtin_shufflevector(a, b, 0, 1, 2, 3, 4, 5, 6, 7); }
__device__ const float LG2G[4] = {-0.04580368961f, -0.02272007651f, -0.01131531323f, -0.005646563141f};

__device__ const double ANGTAB[64] = {1.0, 0.8639884494839686, 0.746476040841712, 0.6449466771037623, 0.5572264795507174, 0.4814372420784346, 0.4159562163071847, 0.3593813663804627, 0.310501349512486, 0.2682695795279726, 0.2317818180600892, 0.20025681360431177, 0.1730195738845894, 0.14948691337092335, 0.1291549665014884, 0.11158839925077482, 0.09641108804907499, 0.08329806647658265, 0.0719685673001152, 0.06218001087320915, 0.05372281118324029, 0.046415888336127774, 0.04010279139495206, 0.034648348557303664, 0.029935772947204897, 0.02586416205275968, 0.02234633726916594, 0.019306977288832496, 0.016681005372000585, 0.014412195967188533, 0.012451970847350322, 0.01075835898542179, 0.00929509789880649, 0.008030857221391512, 0.0069385678787371825, 0.005994842503189405, 0.00517947467923121, 0.0044750062972504475, 0.003866353752192409, 0.0033404849835132425, 0.0028861404414300884, 0.002493592004984158, 0.0021544346900318825, 0.00186140668735512, 0.0016082338776670414, 0.0013894954943731372, 0.0012005080577484068, 0.0010372250954070563, 0.0008961505019466045, 0.0007742636826811268, 0.0006689548786914139, 0.0005779692884153309, 0.0004993587893473147, 0.00043144022614437797, 0.0003727593720314938, 0.000322059791872108, 0.0002782559402207124, 0.0002404099183509969, 0.0002077113925966454, 0.00017946024402973164, 0.0001550515779832623, 0.0001339627724518015, 0.00011574228805920575, 9.999999999999991e-05};
namespace pg8 {
constexpr int BM = 256, BK = 64, HALF = 128, HTB = HALF * BK * 2, NXCD = 8, WGM = 4;
DI int lds_byte(int r, int c) { const int st = (r >> 4) * 2 + (c >> 5), rr = r & 15, cc = c & 31, ob = rr * 64 + cc * 2; return st * 1024 + (ob ^ (((ob >> 9) & 1) << 5)); }
DI void stage_rc(int b, int& R, int& C) { const int st = b / 1024, sb = b % 1024, swz = sb ^ (((sb >> 9) & 1) << 5); R = (st >> 1) * 16 + swz / 64; C = (st & 1) * 32 + (swz % 64) / 2; }
DI int perm32(int rho) { const int n = rho >> 4, i = rho & 15; return 8 * (i >> 2) + 4 * n + (i & 3); }
struct Unit { int pm, pn; };
struct Gemm { const bf16_t* A; const bf16_t* Bt; int lda, K; };
struct StaticOrder {
    int nM, nN, nwg, G, c;
    DI void init(int nM_, int nN_, int G_, int c_) { nM = nM_; nN = nN_; nwg = nM * nN; G = G_; c = c_; }
    DI bool next(int i, Unit& u) const {
        const long L = (long)i * G + c; if (L >= nwg) return false;
        int wgid = (int)L; { const int q = nwg / NXCD, r = nwg % NXCD, xcd = wgid % NXCD, off = wgid / NXCD; wgid = (xcd < r ? xcd * (q + 1) : r * (q + 1) + (xcd - r) * q) + off; }
        const int nig = WGM * nN, gid = wgid / nig, fm = gid * WGM, gsz = (nM - fm) < WGM ? (nM - fm) : WGM;
        u.pm = fm + ((wgid % nig) % gsz); u.pn = (wgid % nig) / gsz; return true;
    }
};
struct BranchOrder {
    int G, c;
    DI bool next(int i, Unit& u) const {
        const int tile = (i >> 2) * G + c, j = i & 3; if (tile >= 512) return false;
        u.pm = j * 64 + (tile >> 3); u.pn = j * 8 + (tile & 7); return true;
    }
};
struct PpOrder {
    int G, c;
    DI bool next(int i, Unit& u) const {
        int L;
        if (G == 256) { if (c < 128) return false; L = i * 128 + (c - 128); } else L = i * G + c;
        if (L >= 512) return false;
        u.pm = L >> 3; u.pn = L & 7; return true;
    }
};
struct GpOrder {
    int G, c;
    DI bool next(int i, Unit& u) const {
        const int L = i * G + c; if (L >= 384) return false;
        if (L < 256) { u.pm = L >> 2; u.pn = L & 3; } else { const int l2 = L - 256; u.pm = 64 + (l2 >> 1); u.pn = 4 + (l2 & 1); }
        return true;
    }
};

template <class Epi, class Sched>
DI void gemm_phase(LAS unsigned char* lds, const Gemm g, const Sched& S, const Epi& E) {
    int tid = tidx(); asm volatile("" : "+v"(tid));
    const int wid = __builtin_amdgcn_readfirstlane(tid >> 6), lane = tid & 63, wr = wid >> 2, wc = wid & 3, fr = lane & 15, fq = lane >> 4;
    const int K = g.K, nt = K / BK, lda = g.lda;
    unsigned voffA[2], voffB[2];
#pragma unroll
    for (int i = 0; i < 2; ++i) { int R, C; stage_rc(tid * 16 + i * 8192, R, C); const int Rb = Epi::PERM ? ((R & ~31) + perm32(R & 31)) : R;
        voffA[i] = (unsigned)(R * lda + C) * 2u; voffB[i] = (unsigned)(Rb * K + C) * 2u; }
    const size_t kstep = (size_t)(BK * 2);
    const size_t hstepA = (size_t)HALF * lda * 2, hstepB = (size_t)HALF * K * 2;
    const size_t tstepA = 2 * hstepA, tstepB = 2 * hstepB;
    const unsigned ldsw = (unsigned)wid * 1024u;
    const int aoff = lds_byte(wr * 64 + fr, fq * 8), boff = lds_byte(wc * 32 + fr, fq * 8);
#define PG8_SA(b, h) (((b) * 2 + (h)) * HTB)
#define PG8_SB(b, h) ((4 + (b) * 2 + (h)) * HTB)
#define PG8_STAGE(bufoff, gbase, voff) do { _Pragma("unroll") for (int _i = 0; _i < 2; ++_i) \
        __builtin_amdgcn_global_load_lds((const unsigned*)((const char*)(gbase) + (voff)[_i]), (LAS unsigned*)(lds + (bufoff) + ldsw + _i * 8192), 16, 0, 0); } while (0)
#define PG8_LDA(dst, b, h) do { _Pragma("unroll") for (int m = 0; m < 4; ++m) _Pragma("unroll") for (int k = 0; k < 2; ++k) dst[m][k] = *(const LAS bf16x8*)(lds + PG8_SA(b, h) + aoff + m * 2048 + k * 1024); } while (0)
#define PG8_LDB(dst, b, h) do { _Pragma("unroll") for (int n = 0; n < 2; ++n) _Pragma("unroll") for (int k = 0; k < 2; ++k) dst[n][k] = *(const LAS bf16x8*)(lds + PG8_SB(b, h) + boff + n * 2048 + k * 1024); } while (0)
#define PG8_MMA(ai, bj, At, Bt) do { __builtin_amdgcn_s_setprio(1); _Pragma("unroll") for (int m = 0; m < 4; ++m) _Pragma("unroll") for (int n = 0; n < 2; ++n) _Pragma("unroll") for (int k = 0; k < 2; ++k) \
        acc[ai][bj][m][n] = __builtin_amdgcn_mfma_f32_16x16x32_bf16(Bt[n][k], At[m][k], acc[ai][bj][m][n], 0, 0, 0); __builtin_amdgcn_s_setprio(0); } while (0)
#define PG8_WAIT_V(n) asm volatile("s_waitcnt vmcnt(" #n ")" ::: "memory")
#define PG8_WAIT_L(n) asm volatile("s_waitcnt lgkmcnt(" #n ")" ::: "memory")
#define PG8_BAR __builtin_amdgcn_s_barrier()
#define PG8_SCHED __builtin_amdgcn_sched_barrier(0)
    Unit cur, nxt; int ui = 0;
    if (!S.next(0, cur)) return;
    f32x4 acc[2][2][4][2];
#pragma unroll
    for (int a = 0; a < 2; ++a)
#pragma unroll
        for (int b = 0; b < 2; ++b)
#pragma unroll
            for (int m = 0; m < 4; ++m)
#pragma unroll
                for (int n = 0; n < 2; ++n) acc[a][b][m][n] = (f32x4){0.f, 0.f, 0.f, 0.f};
    bf16x8 At[4][2], B0[2][2], B1[2][2];
    const char* cA = (const char*)g.A + (size_t)cur.pm * tstepA; const char* cB = (const char*)g.Bt + (size_t)cur.pn * tstepB;
    PG8_STAGE(PG8_SB(0, 0), cB, voffB); PG8_STAGE(PG8_SA(0, 0), cA, voffA); PG8_STAGE(PG8_SB(0, 1), cB + hstepB, voffB); PG8_STAGE(PG8_SA(0, 1), cA + hstepA, voffA);
    if (wr == 1) PG8_BAR;
    PG8_WAIT_V(4); PG8_BAR;
    PG8_STAGE(PG8_SB(1, 0), cB + kstep, voffB); PG8_STAGE(PG8_SA(1, 0), cA + kstep, voffA); PG8_STAGE(PG8_SB(1, 1), cB + hstepB + kstep, voffB);
    PG8_WAIT_V(6); PG8_BAR;
    for (;;) {
        const bool has_next = S.next(ui + 1, nxt);
        const char* nA = has_next ? (const char*)g.A + (size_t)nxt.pm * tstepA : cA; const char* nB = has_next ? (const char*)g.Bt + (size_t)nxt.pn * tstepB : cB;
        for (int t = 0; t < nt; t += 2) {
            const bool last = (t == nt - 2);
            const char* a1 = cA + (size_t)(t + 1) * kstep;
            const char* a2 = last ? nA : cA + (size_t)(t + 2) * kstep; const char* b2 = last ? nB : cB + (size_t)(t + 2) * kstep;
            const char* a3 = a2 + kstep; const char* b3 = b2 + kstep;
            PG8_LDB(B0, 0, 0); PG8_SCHED; PG8_LDA(At, 0, 0); PG8_STAGE(PG8_SA(1, 1), a1 + hstepA, voffA);
            PG8_WAIT_L(8); PG8_BAR; PG8_WAIT_L(0); PG8_MMA(0, 0, At, B0); PG8_BAR; PG8_SCHED;
            PG8_LDB(B1, 0, 1); PG8_STAGE(PG8_SB(0, 0), b2, voffB);
            PG8_BAR; PG8_WAIT_L(0); PG8_MMA(0, 1, At, B1); PG8_BAR;
            PG8_LDA(At, 0, 1); PG8_STAGE(PG8_SA(0, 0), a2, voffA);
            PG8_BAR; PG8_WAIT_L(0); PG8_MMA(1, 0, At, B0); PG8_BAR; PG8_SCHED;
            PG8_STAGE(PG8_SB(0, 1), b2 + hstepB, voffB);
            PG8_WAIT_V(6); PG8_BAR; PG8_MMA(1, 1, At, B1); PG8_BAR;
            PG8_LDB(B0, 1, 0); PG8_SCHED; PG8_LDA(At, 1, 0); PG8_STAGE(PG8_SA(0, 1), a2 + hstepA, voffA);
            PG8_WAIT_L(8); PG8_BAR; PG8_WAIT_L(0); PG8_MMA(0, 0, At, B0); PG8_BAR; PG8_SCHED;
            PG8_LDB(B1, 1, 1); PG8_STAGE(PG8_SB(1, 0), b3, voffB);
            PG8_BAR; PG8_WAIT_L(0); PG8_MMA(0, 1, At, B1); PG8_BAR;
            PG8_LDA(At, 1, 1); PG8_STAGE(PG8_SA(1, 0), a3, voffA);
            PG8_BAR; PG8_WAIT_L(0); PG8_MMA(1, 0, At, B0); PG8_BAR; PG8_SCHED;
            PG8_STAGE(PG8_SB(1, 1), b3 + hstepB, voffB);
            PG8_WAIT_V(6); PG8_BAR; PG8_MMA(1, 1, At, B1); PG8_BAR;
            if constexpr (Epi::HOOK) { if ((t & 7) == 6 && !last) E.hook(acc, cur, t >> 3, wr, wc, fr, fq); }
        }
        E(acc, cur, wr, wc, fr, fq);
        if (Epi::REPEAT) { asm volatile("" ::: "memory"); E(acc, cur, wr, wc, fr, fq); }
        if (!has_next) break;
#pragma unroll
        for (int a = 0; a < 2; ++a)
#pragma unroll
            for (int b = 0; b < 2; ++b)
#pragma unroll
                for (int m = 0; m < 4; ++m)
#pragma unroll
                    for (int n = 0; n < 2; ++n) acc[a][b][m][n] = (f32x4){0.f, 0.f, 0.f, 0.f};
        cur = nxt; cA = nA; cB = nB; ++ui;
    }
    PG8_WAIT_V(0);
    if (wr == 0) PG8_BAR;
    PG8_BAR;
#undef PG8_SA
#undef PG8_SB
#undef PG8_STAGE
#undef PG8_LDA
#undef PG8_LDB
#undef PG8_MMA
#undef PG8_WAIT_V
#undef PG8_WAIT_L
#undef PG8_BAR
#undef PG8_SCHED
}

typedef const f32x4 (&AccT)[2][2][4][2];
DI unsigned q8(float x) { return (unsigned)(sigmoidf_(x) * 255.f + 0.5f); }

struct EpiIn {
    static constexpr bool PERM = true, REPEAT = false, HOOK = false;
    bf16_t* Zm; unsigned char* G8; const f32x2* trig; const float* ss;
    DI void operator()(AccT acc0, const Unit& u, int wr, int wc, int fr, int fq) const {
        const int row0 = u.pm * 256 + wr * 64 + fr, cw = wc * 32 + 8 * fq;
        f32x4 acc[2][2][4][2];
#pragma unroll
        for (int ai = 0; ai < 2; ++ai)
#pragma unroll
            for (int m = 0; m < 4; ++m) { const float rs = ss ? rsqrtf(ss[row0 + ai * 128 + m * 16] * (1.f / 2048.f) + 1e-6f) : 1.f;
#pragma unroll
                for (int bj = 0; bj < 2; ++bj)
#pragma unroll
                    for (int n = 0; n < 2; ++n) acc[ai][bj][m][n] = acc0[ai][bj][m][n] * rs; }
        if (u.pn >= 18) {
            unsigned char* tb = G8 + ((size_t)u.pm * 32 + (u.pn - 18)) * 65536 + (size_t)((wr * 4 + wc) * 64 + fq * 16 + fr) * 16;
#pragma unroll
            for (int ai = 0; ai < 2; ++ai)
#pragma unroll
                for (int m = 0; m < 4; ++m) { unsigned char* rp = tb + (size_t)(ai * 4 + m) * 8192; unsigned ga_[2], gb_[2];
#pragma unroll
                    for (int bj = 0; bj < 2; ++bj) { const f32x4 v0 = acc[ai][bj][m][0], v1 = acc[ai][bj][m][1]; u32x2 w; unsigned a = 0u, b = 0u;
#pragma unroll
                        for (int j = 0; j < 4; ++j) { a = __builtin_amdgcn_cvt_pk_u8_f32(__builtin_rintf(sigmoidf_(v0[j]) * 255.f), j, a); b = __builtin_amdgcn_cvt_pk_u8_f32(__builtin_rintf(sigmoidf_(v1[j]) * 255.f), j, b); }
                        (void)w; ga_[bj] = a; gb_[bj] = b; }
                    *(u32x4*)rp = (u32x4){ga_[0], gb_[0], ga_[1], gb_[1]}; }
        } else {
            const int mode = (u.pn == 17) ? 2 : ((u.pn >= 9 && u.pn <= 12) ? 1 : 0);
            const float ksc = (u.pn >= 11) ? 0.08838834764831845f : 1.f;
#pragma unroll
            for (int ai = 0; ai < 2; ++ai)
#pragma unroll
                for (int m = 0; m < 4; ++m) { const int row = row0 + ai * 128 + m * 16; bf16_t* rp = Zm + (size_t)row * ZW + u.pn * 256 + cw;
                    f32x2 cs[4];
                    if (mode == 1) { const f32x4* tp = (const f32x4*)(trig + (size_t)row * 64 + (cw >> 1)); const f32x4 t0 = tp[0], t1 = tp[1];
                        cs[0] = (f32x2){t0[0], t0[1]}; cs[1] = (f32x2){t0[2], t0[3]}; cs[2] = (f32x2){t1[0], t1[1]}; cs[3] = (f32x2){t1[2], t1[3]}; }
#pragma unroll
                    for (int bj = 0; bj < 2; ++bj) { f32x4 v0 = acc[ai][bj][m][0], v1 = acc[ai][bj][m][1];
                        if (mode == 1) {
                            f32x4 r0, r1;
                            r0[0] = (v0[0] * cs[0].x - v0[1] * cs[0].y) * ksc; r0[1] = (v0[1] * cs[0].x + v0[0] * cs[0].y) * ksc;
                            r0[2] = (v0[2] * cs[1].x - v0[3] * cs[1].y) * ksc; r0[3] = (v0[3] * cs[1].x + v0[2] * cs[1].y) * ksc;
                            r1[0] = (v1[0] * cs[2].x - v1[1] * cs[2].y) * ksc; r1[1] = (v1[1] * cs[2].x + v1[0] * cs[2].y) * ksc;
                            r1[2] = (v1[2] * cs[3].x - v1[3] * cs[3].y) * ksc; r1[3] = (v1[3] * cs[3].x + v1[2] * cs[3].y) * ksc;
                            v0 = r0; v1 = r1;
                        } else if (mode == 2) {
#pragma unroll
                            for (int j = 0; j < 4; ++j) { v0[j] = sigmoidf_(v0[j]); v1[j] = sigmoidf_(v1[j]); }
                        }
                        u32x4 w; w.x = pk2(v0[0], v0[1]); w.y = pk2(v0[2], v0[3]); w.z = pk2(v1[0], v1[1]); w.w = pk2(v1[2], v1[3]);
                        *(u32x4*)(rp + bj * 128) = w; } }
        }
    }
};
#ifndef REP_EPI
#define REP_EPI 0
#endif
template <int ACT> struct EpiBf {
    static constexpr bool PERM = true, REPEAT = (REP_EPI != 0) && (ACT == 1), HOOK = false;
    bf16_t* O; int ldc; const float* ss;
    DI void operator()(AccT acc, const Unit& u, int wr, int wc, int fr, int fq) const {
        const int row0 = u.pm * 256 + wr * 64 + fr, col0 = u.pn * 256 + wc * 32 + 8 * fq;
#pragma unroll
        for (int ai = 0; ai < 2; ++ai)
#pragma unroll
            for (int m = 0; m < 4; ++m) { bf16_t* rp = O + (size_t)(row0 + ai * 128 + m * 16) * ldc + col0;
                const float rs = ss ? rsqrtf(ss[row0 + ai * 128 + m * 16] * (1.f / 2048.f) + 1e-6f) : 1.f;
#pragma unroll
                for (int bj = 0; bj < 2; ++bj) { f32x4 v0 = acc[ai][bj][m][0] * rs, v1 = acc[ai][bj][m][1] * rs;
                    if (ACT == 1) {
#pragma unroll
                        for (int j = 0; j < 4; ++j) { float a = fmaxf(v0[j], 0.f), b = fmaxf(v1[j], 0.f); v0[j] = a * a; v1[j] = b * b; } }
                    u32x4 w; w.x = pk2(v0[0], v0[1]); w.y = pk2(v0[2], v0[3]); w.z = pk2(v1[0], v1[1]); w.w = pk2(v1[2], v1[3]);
                    *(u32x4*)(rp + bj * 128) = w; } }
    }
};
struct EpiGp {
    static constexpr bool PERM = true, REPEAT = false, HOOK = false;
    bf16_t* Os5; bf16_t* Opool; const float* pscale;
    DI void operator()(AccT acc, const Unit& u, int wr, int wc, int fr, int fq) const {
        const int cw = wc * 32 + 8 * fq;
        if (u.pm < 64) {
            const int row0 = u.pm * 256 + wr * 64 + fr, ch0 = u.pn * 128 + cw;
#pragma unroll
            for (int ai = 0; ai < 2; ++ai)
#pragma unroll
                for (int m = 0; m < 4; ++m) { bf16_t* rp = Os5 + (size_t)(row0 + ai * 128 + m * 16) * 2048 + ch0;
                    const f32x4 a0 = acc[ai][0][m][0], a1 = acc[ai][0][m][1], b0 = acc[ai][1][m][0], b1 = acc[ai][1][m][1]; f32x4 v0, v1;
#pragma unroll
                    for (int j = 0; j < 4; ++j) { v0[j] = a0[j] * sigmoidf_(b0[j]); v1[j] = a1[j] * sigmoidf_(b1[j]); }
                    u32x4 w; w.x = pk2(v0[0], v0[1]); w.y = pk2(v0[2], v0[3]); w.z = pk2(v1[0], v1[1]); w.w = pk2(v1[2], v1[3]);
                    *(u32x4*)rp = w; }
        } else {
            const int row0 = (u.pm - 64) * 256 + wr * 64 + fr, col0 = (u.pn - 4) * 256 + cw;
#pragma unroll
            for (int bj = 0; bj < 2; ++bj) { const f32x4 s0 = *(const f32x4*)(pscale + col0 + bj * 128), s1 = *(const f32x4*)(pscale + col0 + bj * 128 + 4);
#pragma unroll
                for (int ai = 0; ai < 2; ++ai)
#pragma unroll
                    for (int m = 0; m < 4; ++m) { bf16_t* rp = Opool + (size_t)(row0 + ai * 128 + m * 16) * 2048 + col0 + bj * 128;
                        const f32x4 v0 = acc[ai][bj][m][0] * s0, v1 = acc[ai][bj][m][1] * s1;
                        u32x4 w; w.x = pk2(v0[0], v0[1]); w.y = pk2(v0[2], v0[3]); w.z = pk2(v1[0], v1[1]); w.w = pk2(v1[2], v1[3]);
                        *(u32x4*)rp = w; } }
        }
    }
};
struct EpiBr {
    static constexpr bool PERM = true, REPEAT = false, HOOK = true;
    const unsigned char* G8; bf16_t* Mb;
    DI static f32x4 unpack(unsigned gq) { f32x4 gv; gv[0] = (float)(gq & 255u); gv[1] = (float)((gq >> 8) & 255u); gv[2] = (float)((gq >> 16) & 255u); gv[3] = (float)(gq >> 24);
        gv[0] = fmaxf(gv[0], 1.f); gv[1] = fmaxf(gv[1], 1.f); gv[2] = fmaxf(gv[2], 1.f); gv[3] = fmaxf(gv[3], 1.f); return gv; }
    DI void hook(f32x4 (&acc)[2][2][4][2], const Unit& u, int j, int wr, int wc, int fr, int fq) const {
        int tix = ((wr * 4 + wc) * 64 + fq * 16 + fr) * 16;
        asm volatile("" : "+v"(tix));
        const unsigned char* ta = G8 + ((size_t)u.pm * 32 + j * 8 + u.pn) * 65536 + tix;
#pragma unroll
        for (int ai = 0; ai < 2; ++ai)
#pragma unroll
            for (int m = 0; m < 4; ++m) { const u32x4 qa = *(const u32x4*)(ta + (ai * 4 + m) * 8192), qb = *(const u32x4*)(ta + 8 * 65536 + (ai * 4 + m) * 8192);
#pragma unroll
                for (int bj = 0; bj < 2; ++bj)
#pragma unroll
                    for (int n = 0; n < 2; ++n) { const f32x4 ga = unpack(qa[bj * 2 + n]), gb = unpack(qb[bj * 2 + n]);
                        f32x4 r; r[0] = ga[0] * __builtin_amdgcn_rcpf(gb[0]); r[1] = ga[1] * __builtin_amdgcn_rcpf(gb[1]); r[2] = ga[2] * __builtin_amdgcn_rcpf(gb[2]); r[3] = ga[3] * __builtin_amdgcn_rcpf(gb[3]);
                        acc[ai][bj][m][n] = acc[ai][bj][m][n] * r; }
                if (m == 3) asm volatile("" ::: "memory"); }
    }
    DI void operator()(AccT acc, const Unit& u, int wr, int wc, int fr, int fq) const {
        const int row0 = u.pm * 256 + wr * 64 + fr, col0 = u.pn * 256 + wc * 32 + 8 * fq;
#pragma unroll
        for (int ai = 0; ai < 2; ++ai)
#pragma unroll
            for (int m = 0; m < 4; ++m) { const int row = row0 + ai * 128 + m * 16;
                const u32x4 q3 = *(const u32x4*)(G8 + ((size_t)u.pm * 32 + 24 + u.pn) * 65536 + (size_t)((ai * 4 + m) * 512 + (wr * 4 + wc) * 64 + fq * 16 + fr) * 16);
#pragma unroll
                for (int bj = 0; bj < 2; ++bj) { const f32x4 v0 = acc[ai][bj][m][0] * unpack(q3[bj * 2]) * (1.f / 255.f), v1 = acc[ai][bj][m][1] * unpack(q3[bj * 2 + 1]) * (1.f / 255.f);
                    u32x4 w; w.x = pk2(v0[0], v0[1]); w.y = pk2(v0[2], v0[3]); w.z = pk2(v1[0], v1[1]); w.w = pk2(v1[2], v1[3]); *(u32x4*)(Mb + (size_t)row * DM + col0 + bj * 128) = w; }
                if (m == 3) asm volatile("" ::: "memory"); }
    }
};
template <int MODE> struct EpiH {
    static constexpr bool PERM = true, REPEAT = false, HOOK = false;
    const float* hin; float* h; bf16_t* hb; const bf16_t* pp; bf16_t* vn; const float* gw; float* ss;
    DI void operator()(AccT acc, const Unit& u, int wr, int wc, int fr, int fq) const {
        const int row0 = u.pm * 256 + wr * 64 + fr, col0 = u.pn * 256 + wc * 32 + 8 * fq;
        f32x4 gv[2][2];
        if (vn) {
#pragma unroll
            for (int bj = 0; bj < 2; ++bj)
#pragma unroll
                for (int n = 0; n < 2; ++n) gv[bj][n] = *(const f32x4*)(gw + col0 + bj * 128 + 4 * n);
        }
#pragma unroll
        for (int ai = 0; ai < 2; ++ai)
#pragma unroll
            for (int m = 0; m < 4; ++m) { const int row = row0 + ai * 128 + m * 16; const size_t ro = (size_t)row * DM + col0; float sq = 0.f;
#pragma unroll
                for (int bj = 0; bj < 2; ++bj) { const size_t o = ro + bj * 128; f32x4 a0 = acc[ai][bj][m][0], a1 = acc[ai][bj][m][1];
                    if (MODE == 2) { const u32x4 pw = *(const u32x4*)(pp + o);
                        a0[0] = sigmoidf_(a0[0]) * bflo(pw.x); a0[1] = sigmoidf_(a0[1]) * bfhi(pw.x); a0[2] = sigmoidf_(a0[2]) * bflo(pw.y); a0[3] = sigmoidf_(a0[3]) * bfhi(pw.y);
                        a1[0] = sigmoidf_(a1[0]) * bflo(pw.z); a1[1] = sigmoidf_(a1[1]) * bfhi(pw.z); a1[2] = sigmoidf_(a1[2]) * bflo(pw.w); a1[3] = sigmoidf_(a1[3]) * bfhi(pw.w); }
                    const f32x4 v0 = *(const f32x4*)(hin + o) + a0, v1 = *(const f32x4*)(hin + o + 4) + a1;
                    *(f32x4*)(h + o) = v0; *(f32x4*)(h + o + 4) = v1;
                    if (MODE == 1) { u32x4 w; w.x = pk2(v0[0], v0[1]); w.y = pk2(v0[2], v0[3]); w.z = pk2(v1[0], v1[1]); w.w = pk2(v1[2], v1[3]); *(u32x4*)(hb + o) = w; }
                    if (vn) { sq += ((v0[0] * v0[0] + v0[1] * v0[1]) + (v0[2] * v0[2] + v0[3] * v0[3])) + ((v1[0] * v1[0] + v1[1] * v1[1]) + (v1[2] * v1[2] + v1[3] * v1[3]));
                        const f32x4 y0 = v0 * gv[bj][0], y1 = v1 * gv[bj][1]; u32x4 w; w.x = pk2(y0[0], y0[1]); w.y = pk2(y0[2], y0[3]); w.z = pk2(y1[0], y1[1]); w.w = pk2(y1[2], y1[3]); *(u32x4*)(vn + o) = w; } }
                if (vn) { sq += __shfl_xor(sq, 16); sq += __shfl_xor(sq, 32); if (fq == 0) atomicAdd(ss + row, sq); }
                if (m == 3) asm volatile("" ::: "memory"); }
    }
};
}

DI int map_in(int n) { if (n < 1280) return n; if (n < 4352) return n + 24; if (n < 4376) return n - 4352 + 1280; if (n < 4608) return -1; return n - 4608 + 4376; }
DI f32x4 wsrc4(const P& p, int L, int task, int n, int k) {
    const float* q = nullptr;
    switch (task) {
    case 0: { const int c = map_in(n); q = c < 0 ? nullptr : p.w_in + ((size_t)L * 2048 + k) * 12568 + c; break; }
    case 1: q = p.w_up + ((size_t)L * 2048 + k) * 8192 + n; break;
    case 2: q = p.w_down + ((size_t)L * 8192 + k) * 2048 + n; break;
    case 3: q = p.w_out + ((size_t)L * 2048 + k) * 2048 + n; break;
    case 4: q = p.w_pg + ((size_t)L * 2048 + k) * 2048 + n; break;
    case 5: q = p.w_branch + ((size_t)L * 2048 + k) * 2048 + n; break;
    case 6: q = p.w_pp + ((size_t)L * 256 + k) * 2048 + n; break;
    case 7: { if (n < 1024) { const int tile = n >> 8, half = (n >> 7) & 1, ch = tile * 128 + (n & 127); q = p.w_glu + ((size_t)L * 512 + k) * 1024 + half * 512 + ch; }
              else { const int c = n - 1024; q = ((k >> 7) == (c >> 7)) ? p.pool_w + (((size_t)L * 4 + (c >> 7)) * 128 + (k & 127)) * 128 + (c & 127) : nullptr; } break; }
    default: { const int kv = n >> 6, e = n & 63; q = (kv ? p.w_cmp_v : p.w_cmp_k) + ((size_t)L * 2048 + k) * 64 + e; break; }
    }
    return q ? *(const f32x4*)q : (f32x4){0.f, 0.f, 0.f, 0.f};
}
DI void conv_phase(const P& p, int L, unsigned char* lds) {
    float* T = (float*)lds;
    const int tid = tidx();
    const int tcnt[9] = {3200, 2048, 2048, 512, 512, 512, 64, 96, 32};
    const int tK[9] = {2048, 2048, 8192, 2048, 2048, 2048, 256, 512, 2048};
    const size_t toff[9] = {OFF_WIN, OFF_WUP, OFF_WDN, OFF_WOUT, OFF_WPG, OFF_WBR, OFF_WPP, OFF_WGP, OFF_WCMP};
    const int nn4 = (tid & 31) * 4, kk = tid >> 5, r = tid >> 2, cq = (tid & 3) * 8;
    for (int it = bidx(); it < 9024; it += gridDim.x) {
        int task = 0, ti = it;
#pragma unroll
        for (int q = 0; q < 8; ++q) if (task == q && ti >= tcnt[q]) { ti -= tcnt[q]; task = q + 1; }
        int K = 0; size_t off = 0;
#pragma unroll
        for (int q = 0; q < 9; ++q) if (task == q) { K = tK[q]; off = toff[q]; }
        const int nkt = K >> 6, n0 = (ti / nkt) * 128, k0 = (ti % nkt) * 64;
        f32x4 v[4];
#pragma unroll
        for (int i = 0; i < 4; ++i) v[i] = wsrc4(p, L, task, n0 + nn4, k0 + kk + 16 * i);
#pragma unroll
        for (int i = 0; i < 4; ++i) *(f32x4*)(T + (kk + 16 * i) * 132 + nn4) = v[i];
        __syncthreads();
#pragma unroll
        for (int ps = 0; ps < 2; ++ps) { const int c8 = cq + 32 * ps;
            u32x4 w; w.x = pk2(T[(c8 + 0) * 132 + r], T[(c8 + 1) * 132 + r]); w.y = pk2(T[(c8 + 2) * 132 + r], T[(c8 + 3) * 132 + r]);
            w.z = pk2(T[(c8 + 4) * 132 + r], T[(c8 + 5) * 132 + r]); w.w = pk2(T[(c8 + 6) * 132 + r], T[(c8 + 7) * 132 + r]);
            *(u32x4*)((bf16_t*)(p.ws + off) + (size_t)(n0 + r) * K + k0 + c8) = w; }
        __syncthreads();
    }
}
DI float red2pi(double a) { return (float)(a - 6.283185307179586 * rint(a * 0.15915494309189535)); }
DI void misc_prep(const P& p, int L) {
    const int gt = bidx() * 512 + tidx(), gs = gridDim.x * 512;
    { const f32x4* src = (const f32x4*)(p.p + (size_t)L * S * 256); u32x2* dst = (u32x2*)(p.ws + OFF_PBF);
      for (int i = gt; i < S * 64; i += gs) { const f32x4 v = src[i]; u32x2 w; w.x = pk2(v[0], v[1]); w.y = pk2(v[2], v[3]); dst[i] = w; } }
    if (L == 0) { f32x2* tr = (f32x2*)(p.ws + OFF_TRIG);
      for (int i = gt; i < S * 64; i += gs) { const int t = i >> 6, k = i & 63; const double ang = (double)t * ANGTAB[k];
          const float r = red2pi(ang); tr[i] = (f32x2){cosf(r), sinf(r)}; } }
    if (gt < 2048) {
        float* sp = (float*)(p.ws + OFF_S5P); const int g = gt >> 6;
        const float dt = expf(p.log_dt[L * 32 + g]), are = p.a_re[L * 2048 + gt], aim = p.a_im[L * 2048 + gt];
        const float mag = expf(are * dt), ph = red2pi((double)aim * (double)dt);
        float ar = mag * cosf(ph), ai = mag * sinf(ph);
        sp[gt] = ar; sp[2048 + gt] = ai;
        const float xr = ar - 1.f, xi = ai, den = 1.f / (are * are + aim * aim);
        const float cr = (xr * are + xi * aim) * den, ci = (xi * are - xr * aim) * den;
        for (int c = 0; c < 16; ++c) { const float br = p.b_re[((size_t)L * 2048 + gt) * 16 + c], bi = p.b_im[((size_t)L * 2048 + gt) * 16 + c];
            sp[8192 + gt * 16 + c] = cr * br - ci * bi; sp[8192 + 32768 + gt * 16 + c] = cr * bi + ci * br; }
        for (int q = 0; q < 7; ++q) { const float nr = ar * ar - ai * ai, ni = 2.f * ar * ai; ar = nr; ai = ni; }
        sp[4096 + gt] = ar; sp[6144 + gt] = ai;
    }
}
template <bool COPY, bool FINAL>
DI void norm_phase(const float* src, float* hcopy, const float* gw, bf16_t* ob, float* of) {
    const int lane = tidx() & 63, wv = bidx() * 8 + (tidx() >> 6), nw = gridDim.x * 8;
    for (int row = wv; row < S; row += nw) {
        const f32x4* sp = (const f32x4*)(src + (size_t)row * DM); f32x4 v[8]; float ss = 0.f;
#pragma unroll
        for (int i = 0; i < 8; ++i) { v[i] = sp[lane + 64 * i]; ss += v[i][0] * v[i][0] + v[i][1] * v[i][1] + v[i][2] * v[i][2] + v[i][3] * v[i][3]; }
#pragma unroll
        for (int o = 32; o > 0; o >>= 1) ss += __shfl_xor(ss, o);
        const float rs = rsqrtf(ss * (1.f / 2048.f) + 1e-6f);
#pragma unroll
        for (int i = 0; i < 8; ++i) { const f32x4 gv = ((const f32x4*)gw)[lane + 64 * i]; const f32x4 y = v[i] * rs * gv;
            if (COPY) ((f32x4*)(hcopy + (size_t)row * DM))[lane + 64 * i] = v[i];
            if (FINAL) ((f32x4*)(of + (size_t)row * DM))[lane + 64 * i] = y;
            else { u32x2 w; w.x = pk2(y[0], y[1]); w.y = pk2(y[2], y[3]); ((u32x2*)(ob + (size_t)row * DM))[lane + 64 * i] = w; } }
    }
}

DI void compress_phase(const P& p, unsigned char* lds) {
    const int tid = tidx(), w = tid >> 6, lane = tid & 63, ql = lane & 31, hh = lane >> 5;
    const bf16_t* Zm = (const bf16_t*)(p.ws + OFF_ZM); const bf16_t* Wc = (const bf16_t*)(p.ws + OFF_WCMP);
    bf16_t* KC = (bf16_t*)(p.ws + OFF_KC); bf16_t* VCT = (bf16_t*)(p.ws + OFF_VCT);
    float* red = (float*)lds;
    for (int task = bidx(); task < 256; task += gridDim.x) {
        const int et = task & 1, ntile = (task >> 1) & 31, g = (task >> 6) & 1, kv = task >> 7;
        const bf16_t* ap = Zm + (size_t)(16 * (ntile * 32 + ql)) * ZW + ZC_KV + kv * 128 + g * 64 + 8 * hh;
        const bf16_t* bp = Wc + (size_t)(kv * 64 + et * 32 + ql) * 2048 + 8 * hh;
        f32x16 acc = zero16();
#pragma unroll 8
        for (int s = 16 * w; s < 16 * w + 16; ++s) { const bf16x8 a = *(const bf16x8*)(ap + (size_t)(s >> 2) * ZW + 16 * (s & 3)); const bf16x8 b = *(const bf16x8*)(bp + 16 * s); acc = MFMA32(a, b, acc); }
#pragma unroll
        for (int i = 0; i < 16; ++i) red[(w * 16 + i) * 64 + lane] = acc[i];
        __syncthreads();
        if (w == 0) {
#pragma unroll
            for (int i = 0; i < 16; ++i) { float t = 0.f;
#pragma unroll
                for (int q = 0; q < 8; ++q) t += red[(q * 16 + i) * 64 + lane];
                acc[i] = t; }
            const int e = et * 32 + ql;
            if (kv == 0) {
#pragma unroll
                for (int i = 0; i < 16; ++i) { const int n = ntile * 32 + crow(i, hh); KC[((size_t)g * 1024 + n) * 64 + e] = (n < 1023) ? f2bf(acc[i]) : (bf16_t)0; }
            } else {
#pragma unroll
                for (int gi = 0; gi < 4; ++gi) { const int n = ntile * 32 + 8 * gi + 4 * hh; u32x2 wv; wv.x = pk2(acc[4 * gi], acc[4 * gi + 1]); wv.y = pk2(acc[4 * gi + 2], (n + 3 < 1023) ? acc[4 * gi + 3] : 0.f);
                    *(u32x2*)(VCT + ((size_t)g * 64 + e) * 1024 + n) = wv; }
            }
        }
        __syncthreads();
    }
}
DI void vt_pool_phase(const P& p) {
    const bf16_t* Zm = (const bf16_t*)(p.ws + OFF_ZM);
    const int gt = bidx() * 512 + tidx(), gs = gridDim.x * 512;
    bf16_t* VT = (bf16_t*)(p.ws + OFF_VT);
    for (int i = gt; i < 4 * 64 * 2048; i += gs) { const int d = i & 63, t8 = (i >> 6) & 2047, bg = i >> 17; const int br = bg >> 1, g = bg & 1;
        const bf16_t* sp = Zm + (size_t)(t8 * 8) * ZW + ZC_KV + (3 + 2 * br) * 128 + g * 64 + d; unsigned short v[8];
#pragma unroll
        for (int j = 0; j < 8; ++j) v[j] = sp[(size_t)j * ZW];
        u32x4 w; w.x = v[0] | ((unsigned)v[1] << 16); w.y = v[2] | ((unsigned)v[3] << 16); w.z = v[4] | ((unsigned)v[5] << 16); w.w = v[6] | ((unsigned)v[7] << 16);
        *(u32x4*)(VT + ((size_t)bg * 64 + d) * S + t8 * 8) = w; }
    bf16_t* DP = (bf16_t*)(p.ws + OFF_R2) + (size_t)S * 512;
    for (int i = gt; i < S * 64; i += gs) { const int c8 = (i & 63) * 8, t = i >> 6, w = 2 << (c8 >> 7); const int cnt = (t + 1 < w) ? t + 1 : w;
        float sum[8];
#pragma unroll
        for (int j = 0; j < 8; ++j) sum[j] = 0.f;
        u32x4 self = {0, 0, 0, 0};
        for (int q = 0; q < cnt; ++q) { const u32x4 v = *(const u32x4*)(Zm + (size_t)(t - q) * ZW + ZC_POOL + c8); if (q == 0) self = v;
            sum[0] += bflo(v.x); sum[1] += bfhi(v.x); sum[2] += bflo(v.y); sum[3] += bfhi(v.y); sum[4] += bflo(v.z); sum[5] += bfhi(v.z); sum[6] += bflo(v.w); sum[7] += bfhi(v.w); }
        const float ic = 1.f / (float)cnt; u32x4 o;
        o.x = pk2(sum[0] * ic - bflo(self.x), sum[1] * ic - bfhi(self.x)); o.y = pk2(sum[2] * ic - bflo(self.y), sum[3] * ic - bfhi(self.y));
        o.z = pk2(sum[4] * ic - bflo(self.z), sum[5] * ic - bfhi(self.z)); o.w = pk2(sum[6] * ic - bflo(self.w), sum[7] * ic - bfhi(self.w));
        *(u32x4*)(DP + (size_t)t * 512 + c8) = o; }
}

DI void s5_wave(const P& p, int L, unsigned char* wl, int g, int c, bool out) {
    const int lane = tidx() & 63, ql = lane & 31, hh = lane >> 5;
    float* us = (float*)wl; bf16_t* Hs = (bf16_t*)(wl + 8192);
    const float* sp = (const float*)(p.ws + OFF_S5P); const bf16_t* Zm = (const bf16_t*)(p.ws + OFF_ZM);
    const int gn0 = g * 64 + ql, gn1 = gn0 + 32;
    const float ar0 = sp[gn0], ai0 = sp[2048 + gn0], ar1 = sp[gn1], ai1 = sp[2048 + gn1];
    bf16x8 Bf[4];
#pragma unroll
    for (int ct = 0; ct < 4; ++ct) { const float* bp = sp + 8192 + (ct >> 1) * 32768 + (g * 64 + (ct & 1) * 32 + ql) * 16 + 8 * hh; const f32x4 x = *(const f32x4*)bp, y = *(const f32x4*)(bp + 4);
        u32x4 w; w.x = pk2(x[0], x[1]); w.y = pk2(x[2], x[3]); w.z = pk2(y[0], y[1]); w.w = pk2(y[2], y[3]); Bf[ct] = __builtin_bit_cast(bf16x8, w); }
    const bf16_t* Zu = Zm + (size_t)(c * 128) * ZW + ZC_S5 + g * 16;
    float h0r = 0.f, h0i = 0.f, h1r = 0.f, h1i = 0.f;
    f32x2* E = (f32x2*)(p.ws + OFF_S5E) + (size_t)g * 128 * 64;
    bf16x8 Cf[4]; f32x4 dsk4 = {0.f, 0.f, 0.f, 0.f};
    if (out) {
#pragma unroll
        for (int i = 0; i < 4; ++i) { const int e = lane + 64 * i, t = e >> 1, hf = e & 1; const u32x4 v = *(const u32x4*)(Zu + (size_t)t * ZW + hf * 8);
            *(f32x4*)(us + t * 16 + hf * 8) = (f32x4){bflo(v.x), bfhi(v.x), bflo(v.y), bfhi(v.y)}; *(f32x4*)(us + t * 16 + hf * 8 + 4) = (f32x4){bflo(v.z), bfhi(v.z), bflo(v.w), bfhi(v.w)}; }
        const float a0r = sp[4096 + gn0], a0i = sp[6144 + gn0], a1r = sp[4096 + gn1], a1i = sp[6144 + gn1];
#pragma unroll 16
        for (int cc = 0; cc < c; ++cc) { const f32x2 e0 = E[cc * 64 + ql], e1 = E[cc * 64 + 32 + ql];
            float nr = a0r * h0r - a0i * h0i + e0.x, ni = a0r * h0i + a0i * h0r + e0.y; h0r = nr; h0i = ni;
            nr = a1r * h1r - a1i * h1i + e1.x; ni = a1r * h1i + a1i * h1r + e1.y; h1r = nr; h1i = ni; }
        const int cch = lane & 15, quad = lane >> 4;
#pragma unroll
        for (int s = 0; s < 4; ++s) { const float* cp = ((s < 2) ? p.c_re : p.c_im) + (((size_t)L * 32 + g) * 16 + cch) * 64 + 32 * (s & 1) + quad * 8; const float sg = (s < 2) ? 1.f : -1.f;
            const f32x4 x = *(const f32x4*)cp, y = *(const f32x4*)(cp + 4); u32x4 w; w.x = pk2(sg * x[0], sg * x[1]); w.y = pk2(sg * x[2], sg * x[3]); w.z = pk2(sg * y[0], sg * y[1]); w.w = pk2(sg * y[2], sg * y[3]);
            Cf[s] = __builtin_bit_cast(bf16x8, w); }
        dsk4 = *(const f32x4*)(p.s5_d + L * 512 + g * 16 + quad * 4);
        wave_sync();
    }
    bf16_t* YS = (bf16_t*)(p.ws + OFF_R2);
    bf16x8 ufa[4];
#pragma unroll
    for (int tb = 0; tb < 4; ++tb) ufa[tb] = *(const bf16x8*)(Zu + (size_t)(tb * 32 + ql) * ZW + 8 * hh);
#pragma unroll
    for (int tb = 0; tb < 4; ++tb) {
        const bf16x8 uf = ufa[tb];
        f32x16 Bu[4];
#pragma unroll
        for (int ct = 0; ct < 4; ++ct) Bu[ct] = MFMA32(uf, Bf[ct], zero16());
#pragma unroll
        for (int k = 0; k < 4; ++k) {
#pragma unroll
            for (int half = 0; half < 2; ++half) {
                if (hh == half) {
#pragma unroll
                    for (int r = 4 * k; r < 4 * k + 4; ++r) {
                        float nr = ar0 * h0r - ai0 * h0i + Bu[0][r], ni = ar0 * h0i + ai0 * h0r + Bu[2][r]; h0r = nr; h0i = ni; Bu[0][r] = nr; Bu[2][r] = ni;
                        nr = ar1 * h1r - ai1 * h1i + Bu[1][r]; ni = ar1 * h1i + ai1 * h1r + Bu[3][r]; h1r = nr; h1i = ni; Bu[1][r] = nr; Bu[3][r] = ni; }
                }
                const float x0 = __shfl_xor(h0r, 32), x1 = __shfl_xor(h0i, 32), x2 = __shfl_xor(h1r, 32), x3 = __shfl_xor(h1i, 32);
                if (hh != half) { h0r = x0; h0i = x1; h1r = x2; h1i = x3; }
            }
        }
        if (out) {
#pragma unroll
            for (int i = 0; i < 16; ++i) { const int tl = crow(i, hh); bf16_t* hp = Hs + tl * 136 + ql;
                hp[0] = f2bf(Bu[0][i]); hp[32] = f2bf(Bu[1][i]); hp[64] = f2bf(Bu[2][i]); hp[96] = f2bf(Bu[3][i]); }
            wave_sync();
            const int cch = lane & 15, quad = lane >> 4;
#pragma unroll
            for (int rt = 0; rt < 2; ++rt) { f32x4 acc = {0.f, 0.f, 0.f, 0.f};
#pragma unroll
                for (int s = 0; s < 4; ++s) { const bf16x8 av = *(const bf16x8*)(Hs + (rt * 16 + cch) * 136 + 32 * s + quad * 8); acc = MFMA16(Cf[s], av, acc); }
                const int t = tb * 32 + rt * 16 + cch; const f32x4 u4 = *(const f32x4*)(us + t * 16 + quad * 4);
                const float y0 = gelu_tanh(acc[0] + dsk4[0] * u4[0]), y1 = gelu_tanh(acc[1] + dsk4[1] * u4[1]), y2 = gelu_tanh(acc[2] + dsk4[2] * u4[2]), y3 = gelu_tanh(acc[3] + dsk4[3] * u4[3]);
                u32x2 w; w.x = pk2(y0, y1); w.y = pk2(y2, y3); *(u32x2*)(YS + (size_t)(c * 128 + t) * 512 + g * 16 + quad * 4) = w; }
            wave_sync();
        }
    }
    if (!out && hh == 0) { E[c * 64 + ql] = (f32x2){h0r, h0i}; E[c * 64 + 32 + ql] = (f32x2){h1r, h1i}; }
}
DI void s5_phase(const P& p, int L, unsigned char* lds, bool out) {
    const int wid = tidx() >> 6; unsigned char* wl = lds + wid * 16896;
    if (gridDim.x == 256) {
        const int slot = bidx() * 8 + wid, g = slot >> 6, cb = slot & 63;
        s5_wave(p, L, wl, g, cb, out);
        if (out || cb != 0) s5_wave(p, L, wl, g, 127 - cb, out);
    } else {
        const int nchunk = out ? 128 : 127;
        for (int it = bidx() * 8 + wid; it < 32 * nchunk; it += gridDim.x * 8) s5_wave(p, L, wl, it / nchunk, it % nchunk, out);
    }
}

DI void ret_load_T(const bf16_t* src, bf16_t* dst, int h, float lg, bool zeta) {
    const int tid = tidx();
#pragma unroll
    for (int it = 0; it < 4; ++it) { const int e = tid + 512 * it, m = e & 127, d8 = (e >> 7) * 8; const u32x4 v = *(const u32x4*)(src + (size_t)m * ZW + h * 128 + d8);
        const float z = zeta ? exp2f((float)(127 - m) * lg) : 1.f;
        const float f[8] = {bflo(v.x), bfhi(v.x), bflo(v.y), bfhi(v.y), bflo(v.z), bfhi(v.z), bflo(v.w), bfhi(v.w)};
#pragma unroll
        for (int j = 0; j < 8; ++j) dst[(d8 + j) * 136 + m] = f2bf(f[j] * z); }
}
DI void ret_pass1(const P& p, unsigned char* lds, int c, int h) {
    bf16_t* Kt = (bf16_t*)lds; bf16_t* Vt = Kt + 128 * 136;
    const bf16_t* Zm = (const bf16_t*)(p.ws + OFF_ZM) + (size_t)(c * 128) * ZW;
    const float lg = LG2G[h];
    ret_load_T(Zm + ZC_RK, Kt, h, lg, true); ret_load_T(Zm + ZC_RV, Vt, h, lg, false);
    __syncthreads();
    const int w = tidx() >> 6, lane = tidx() & 63, ql = lane & 31, hh = lane >> 5, et = w >> 1, dh2 = w & 1;
    f32x16 acc[2] = {zero16(), zero16()};
#pragma unroll
    for (int s = 0; s < 8; ++s) { const bf16x8 a = *(const bf16x8*)(Vt + (32 * et + ql) * 136 + 16 * s + 8 * hh);
#pragma unroll
        for (int dt = 0; dt < 2; ++dt) { const bf16x8 b = *(const bf16x8*)(Kt + (64 * dh2 + 32 * dt + ql) * 136 + 16 * s + 8 * hh); acc[dt] = MFMA32(a, b, acc[dt]); } }
    float* out = (float*)(p.ws + OFF_KVT) + (size_t)(c * 4 + h) * 16384;
#pragma unroll
    for (int dt = 0; dt < 2; ++dt)
#pragma unroll
        for (int i = 0; i < 16; ++i) out[(32 * et + crow(i, hh)) * 128 + 64 * dh2 + 32 * dt + ql] = acc[dt][i];
    __syncthreads();
}
DI void ret_prefix(const P& p, int item) {
    const int idx4 = item * 512 + tidx(), h = idx4 >> 12; const float gC = exp2f(128.f * LG2G[h]);
    const f32x4* kv = (const f32x4*)(p.ws + OFF_KVT) + idx4; u32x2* st = (u32x2*)(p.ws + OFF_STT) + idx4;
    f32x4 s = {0.f, 0.f, 0.f, 0.f};
#pragma unroll 16
    for (int c = 0; c < 128; ++c) { u32x2 w; w.x = pk2(s[0], s[1]); w.y = pk2(s[2], s[3]); st[(size_t)c * 16384] = w; if (c < 127) s = s * gC + kv[(size_t)c * 16384]; }
}
DI void ret_pass3(const P& p, unsigned char* lds, int c, int h) {
    bf16_t* Vt = (bf16_t*)lds; float* Yf = (float*)(lds + 34816);
    const bf16_t* Zm = (const bf16_t*)(p.ws + OFF_ZM) + (size_t)(c * 128) * ZW;
    const float lg = LG2G[h];
    ret_load_T(Zm + ZC_RV, Vt, h, lg, false);
    __syncthreads();
    const int w = tidx() >> 6, lane = tidx() & 63, ql = lane & 31, hh = lane >> 5, nt = w >> 1, eh = w & 1, n0 = 32 * nt, e0 = 64 * eh;
    bf16x8 qf[8];
#pragma unroll
    for (int s = 0; s < 8; ++s) qf[s] = *(const bf16x8*)(Zm + (size_t)(n0 + ql) * ZW + ZC_RQ + h * 128 + 16 * s + 8 * hh);
    f32x16 o[2] = {zero16(), zero16()}, cr[2] = {zero16(), zero16()};
    for (int mt = 0; mt <= nt; ++mt) {
        f32x16 sa = zero16();
#pragma unroll
        for (int s = 0; s < 8; ++s) { const bf16x8 kf = *(const bf16x8*)(Zm + (size_t)(32 * mt + ql) * ZW + ZC_RK + h * 128 + 16 * s + 8 * hh); sa = MFMA32(kf, qf[s], sa); }
        const int n = n0 + ql;
#pragma unroll
        for (int i = 0; i < 16; ++i) { const int m = 32 * mt + crow(i, hh); sa[i] = (n >= m) ? sa[i] * exp2f((float)(n - m) * lg) : 0.f; }
        const bf16x8 pb0 = pack8(sa, 0), pb1 = pack8(sa, 1);
#pragma unroll
        for (int et = 0; et < 2; ++et) { const bf16_t* vp = Vt + (e0 + 32 * et + ql) * 136 + 32 * mt + 4 * hh;
            o[et] = MFMA32(cat4(*(const s16x4*)vp, *(const s16x4*)(vp + 8)), pb0, o[et]);
            o[et] = MFMA32(cat4(*(const s16x4*)(vp + 16), *(const s16x4*)(vp + 24)), pb1, o[et]); }
    }
    const bf16_t* st = (const bf16_t*)(p.ws + OFF_STT) + (size_t)(c * 4 + h) * 16384;
#pragma unroll
    for (int s = 0; s < 8; ++s)
#pragma unroll
        for (int et = 0; et < 2; ++et) { const bf16x8 a = *(const bf16x8*)(st + (e0 + 32 * et + ql) * 128 + 16 * s + 8 * hh); cr[et] = MFMA32(a, qf[s], cr[et]); }
    const float xi = exp2f((float)(n0 + ql + 1) * lg);
#pragma unroll
    for (int et = 0; et < 2; ++et)
#pragma unroll
        for (int i = 0; i < 16; ++i) Yf[(n0 + ql) * 129 + e0 + 32 * et + crow(i, hh)] = o[et][i] + xi * cr[et][i];
    __syncthreads();
    { const int n = tidx() >> 2, part = tidx() & 3; const float* yp = Yf + n * 129 + part * 32; float ss = 0.f;
#pragma unroll
      for (int e = 0; e < 32; ++e) ss += yp[e] * yp[e];
      ss += __shfl_xor(ss, 1); ss += __shfl_xor(ss, 2);
      const float rs = rsqrtf(ss * (1.f / 128.f) + 1e-6f);
      const bf16_t* gp = Zm + (size_t)n * ZW + ZC_RG + h * 128 + part * 32; bf16_t* op = (bf16_t*)(p.ws + OFF_O4) + (size_t)(c * 128 + n) * 2048 + 1536 + h * 128 + part * 32;
#pragma unroll
      for (int e8 = 0; e8 < 4; ++e8) { const u32x4 gv = *(const u32x4*)(gp + e8 * 8); const float gf[8] = {bflo(gv.x), bfhi(gv.x), bflo(gv.y), bfhi(gv.y), bflo(gv.z), bfhi(gv.z), bflo(gv.w), bfhi(gv.w)}; float r[8];
#pragma unroll
          for (int j = 0; j < 8; ++j) r[j] = gf[j] * sigmoidf_(gf[j]) * yp[e8 * 8 + j] * rs;
          u32x4 w; w.x = pk2(r[0], r[1]); w.y = pk2(r[2], r[3]); w.z = pk2(r[4], r[5]); w.w = pk2(r[6], r[7]); *(u32x4*)(op + e8 * 8) = w; } }
    __syncthreads();
}

struct AttSt { f32x16 o[2]; float m2, l; };
struct KVStage { u32x4 k, v; };
constexpr int KVB_K = 0, KVB_V = 9216, KVB_SZ = 17920;
constexpr int NSA_SEL = 64 * 257 * 4, NSA_UM = NSA_SEL + 2048, NSA_KVB = NSA_UM + 128;
constexpr float SC2 = 0.125f * 1.4426950408889634f;
DI void kv_issue(KVStage& r, const bf16_t* K, size_t ldk, const bf16_t* Vt, size_t ldv, int kb, int tid) {
    const int row = tid >> 3, ch = tid & 7;
    r.k = *(const u32x4*)(K + (size_t)(kb + row) * ldk + ch * 8);
    r.v = *(const u32x4*)(Vt + (size_t)row * ldv + kb + ch * 8);
}
DI void kv_commit(const KVStage& r, unsigned char* buf, int tid) {
    const int row = tid >> 3, ch = tid & 7;
    *(u32x4*)(buf + KVB_K + row * 144 + ch * 16) = r.k;
    unsigned char* vp = buf + KVB_V + row * 136 + ch * 16;
    *(u32x2*)vp = (u32x2){r.v.x, r.v.y}; *(u32x2*)(vp + 8) = (u32x2){r.v.z, r.v.w};
}
DI int slc_next(const unsigned* um, int j, int qt) { for (++j; j <= qt; ++j) if ((um[j >> 5] >> (j & 31)) & 1u) return j; return -1; }
DI float fexp2(float x) { return __builtin_amdgcn_exp2f(x); }

template <int MODE>
DI void nsa_tile(const unsigned char* buf, const bf16x8 (&qf)[4], AttSt& a, int kb, int t, int tq0, int qt, int cur, unsigned bit, float Mfix, float inv, unsigned* imp, int qrow, int ql, int hh) {
    if (MODE == 2 && __ballot(bit) == 0ull) return;
    f32x16 sa[2];
#pragma unroll
    for (int u = 0; u < 2; ++u) { const unsigned char* kp = buf + KVB_K + (u * 32 + ql) * 144 + hh * 16; sa[u] = zero16();
#pragma unroll
        for (int s = 0; s < 4; ++s) sa[u] = MFMA32(*(const bf16x8*)(kp + 32 * s), qf[s], sa[u]); }
    if (MODE == 0) {
        float mx = -1e30f;
#pragma unroll
        for (int u = 0; u < 2; ++u)
#pragma unroll
            for (int i = 0; i < 16; ++i) { const int n = kb + u * 32 + crow(i, hh); sa[u][i] = (16 * n + 31 <= t) ? sa[u][i] * SC2 : -1e30f; mx = fmaxf(mx, sa[u][i]); }
        const float mn = fmaxf(a.m2, mx); float ls = 0.f;
#pragma unroll
        for (int u = 0; u < 2; ++u)
#pragma unroll
            for (int i = 0; i < 16; ++i) ls += (sa[u][i] > -1e29f) ? fexp2(sa[u][i] - mn) : 0.f;
        a.l = a.l * fexp2(a.m2 - mn) + ls; a.m2 = mn;
        return;
    }
    if (MODE == 1) {
#pragma unroll
        for (int u = 0; u < 2; ++u) {
#pragma unroll
            for (int i = 0; i < 16; ++i) { const int n = kb + u * 32 + crow(i, hh); sa[u][i] = (16 * n + 31 <= t) ? fexp2(sa[u][i] * SC2 - Mfix) * inv : 0.f; }
#pragma unroll
            for (int gi = 0; gi < 4; ++gi) { const float a4 = (sa[u][4 * gi] + sa[u][4 * gi + 1]) + (sa[u][4 * gi + 2] + sa[u][4 * gi + 3]); const int j = (kb >> 2) + 8 * u + 2 * gi + hh;
                const unsigned ua = (unsigned)(a4 * 67108864.f), ub = (unsigned)(sa[u][4 * gi + 3] * 67108864.f);
                if (ua) atomicAdd(&imp[qrow * 257 + j], ua);
                if (ub && j + 1 < 256) atomicAdd(&imp[qrow * 257 + j + 1], ub); } }
    } else {
        bool need_mask;
        if (MODE == 2) need_mask = (cur == qt); else need_mask = (kb + 63 > tq0) || (kb < tq0 - 504);
        float mn;
        if (need_mask) {
            float mx = -1e30f; unsigned vm = 0u;
#pragma unroll
            for (int u = 0; u < 2; ++u)
#pragma unroll
                for (int i = 0; i < 16; ++i) { const int key = kb + u * 32 + crow(i, hh); const bool vis = (MODE == 2) ? (bit && key <= t) : (key <= t && key > t - 512);
                    sa[u][i] = vis ? sa[u][i] * SC2 : -1e30f; mx = fmaxf(mx, sa[u][i]); }
            (void)vm;
            mx = fmaxf(mx, __shfl_xor(mx, 32)); mn = fmaxf(a.m2, mx);
#pragma unroll
            for (int u = 0; u < 2; ++u)
#pragma unroll
                for (int i = 0; i < 16; ++i) sa[u][i] = (sa[u][i] > -1e29f) ? fexp2(sa[u][i] - mn) : 0.f;
        } else {
            float mx = -1e30f;
#pragma unroll
            for (int u = 0; u < 2; ++u)
#pragma unroll
                for (int i = 0; i < 16; ++i) mx = fmaxf(mx, sa[u][i]);
            mx *= SC2;
            if (MODE == 2 && !bit) mx = -1e30f;
            mx = fmaxf(mx, __shfl_xor(mx, 32)); mn = fmaxf(a.m2, mx);
            const float mref = (MODE == 2 && !bit) ? 1e30f : mn;
#pragma unroll
            for (int u = 0; u < 2; ++u)
#pragma unroll
                for (int i = 0; i < 16; ++i) sa[u][i] = fexp2(__builtin_fmaf(sa[u][i], SC2, -mref));
        }
        if (__ballot(mn > a.m2) != 0ull) { const float al = fexp2(a.m2 - mn); a.l *= al;
#pragma unroll
            for (int i = 0; i < 16; ++i) { a.o[0][i] *= al; a.o[1][i] *= al; } }
        a.m2 = mn; float ls = 0.f;
#pragma unroll
        for (int u = 0; u < 2; ++u)
#pragma unroll
            for (int i = 0; i < 16; ++i) ls += sa[u][i];
        a.l += ls;
    }
#pragma unroll
    for (int u = 0; u < 2; ++u) { const bf16x8 pb0 = pack8(sa[u], 0), pb1 = pack8(sa[u], 1);
#pragma unroll
        for (int dt = 0; dt < 2; ++dt) { const unsigned char* vp = buf + KVB_V + (32 * dt + ql) * 136 + (u * 32 + 4 * hh) * 2;
            a.o[dt] = MFMA32(cat4(*(const s16x4*)vp, *(const s16x4*)(vp + 16)), pb0, a.o[dt]);
            a.o[dt] = MFMA32(cat4(*(const s16x4*)(vp + 32), *(const s16x4*)(vp + 48)), pb1, a.o[dt]); } }
}
template <int MODE>
DI void nsa_branch(unsigned char* lds, const bf16_t* K, size_t ldk, const bf16_t* Vt, size_t ldv, const bf16x8 (&qf)[4], AttSt& a, int t, int tq0, int qt, float Mfix, float inv, int qrow, int tid, int ql, int hh) {
    unsigned* imp = (unsigned*)lds; const unsigned* sel = (const unsigned*)(lds + NSA_SEL); const unsigned* um = (const unsigned*)(lds + NSA_UM); unsigned char* kvb = lds + NSA_KVB;
    const int q0 = qt * 64;
    const int ntc = ((4 * qt + 2) >> 6) + 1, kb0w = (q0 >= 512) ? q0 - 512 : 0, ntw = ((q0 - kb0w) >> 6) + 1;
    int cur = 0, bsel = 0;
    KVStage st;
    kv_issue(st, K, ldk, Vt, ldv, (MODE == 3) ? kb0w : 0, tid); kv_commit(st, kvb, tid);
    __syncthreads();
    while (cur >= 0) {
        int nxt;
        if (MODE == 2) nxt = slc_next(um, cur, qt); else nxt = (cur + 1 < ((MODE == 3) ? ntw : ntc)) ? cur + 1 : -1;
        const int kbn = (MODE == 3) ? kb0w + 64 * nxt : 64 * nxt;
        if (nxt >= 0) kv_issue(st, K, ldk, Vt, ldv, kbn, tid);
        const int kb = (MODE == 3) ? kb0w + 64 * cur : 64 * cur;
        unsigned bit = 1u;
        if (MODE == 2) bit = (sel[qrow * 8 + (cur >> 5)] >> (cur & 31)) & 1u;
        nsa_tile<MODE>(kvb + bsel * KVB_SZ, qf, a, kb, t, tq0, qt, cur, bit, Mfix, inv, imp, qrow, ql, hh);
        if (nxt >= 0) kv_commit(st, kvb + (bsel ^ 1) * KVB_SZ, tid);
        __syncthreads();
        bsel ^= 1; cur = nxt;
    }
}
DI void nsa_branch_slc2(unsigned char* lds, const bf16_t* K, size_t ldk, const bf16_t* Vt, size_t ldv, const bf16x8 (&qf)[4], AttSt& a, int t, int tq0, int qt, int qrow, int tid, int ql, int hh) {
    unsigned* imp = (unsigned*)lds; const unsigned* sel = (const unsigned*)(lds + NSA_SEL); const unsigned* um = (const unsigned*)(lds + NSA_UM); unsigned char* kvb = lds + NSA_KVB;
    int c0 = 0, c1 = slc_next(um, 0, qt), bsel = 0;
    KVStage s0, s1;
    kv_issue(s0, K, ldk, Vt, ldv, 0, tid); if (c1 >= 0) kv_issue(s1, K, ldk, Vt, ldv, 64 * c1, tid);
    kv_commit(s0, kvb, tid); if (c1 >= 0) kv_commit(s1, kvb + KVB_SZ, tid);
    __syncthreads();
    while (c0 >= 0) {
        const int n0 = (c1 >= 0) ? slc_next(um, c1, qt) : -1, n1 = (n0 >= 0) ? slc_next(um, n0, qt) : -1;
        if (n0 >= 0) kv_issue(s0, K, ldk, Vt, ldv, 64 * n0, tid);
        if (n1 >= 0) kv_issue(s1, K, ldk, Vt, ldv, 64 * n1, tid);
        unsigned char* cb = kvb + bsel * 2 * KVB_SZ;
        { const unsigned bit = (sel[qrow * 8 + (c0 >> 5)] >> (c0 & 31)) & 1u; nsa_tile<2>(cb, qf, a, 64 * c0, t, tq0, qt, c0, bit, 0.f, 0.f, imp, qrow, ql, hh); }
        if (c1 >= 0) { const unsigned bit = (sel[qrow * 8 + (c1 >> 5)] >> (c1 & 31)) & 1u; nsa_tile<2>(cb + KVB_SZ, qf, a, 64 * c1, t, tq0, qt, c1, bit, 0.f, 0.f, imp, qrow, ql, hh); }
        unsigned char* nb = kvb + (bsel ^ 1) * 2 * KVB_SZ;
        if (n0 >= 0) kv_commit(s0, nb, tid);
        if (n1 >= 0) kv_commit(s1, nb + KVB_SZ, tid);
        __syncthreads();
        bsel ^= 1; c0 = n0; c1 = n1;
    }
}
DI void nsa_item(const P& p, unsigned char* lds, int g, int qt) {
    const int tid = tidx(), wid = tid >> 6, lane = tid & 63, ql = lane & 31, hh = lane >> 5;
    const int hd = g * 4 + (ql & 3), tq0 = qt * 64 + wid * 8, t = tq0 + (ql >> 2), qrow = wid * 8 + (ql >> 2);
    unsigned* imp = (unsigned*)lds; unsigned* sel = (unsigned*)(lds + NSA_SEL); unsigned* um = (unsigned*)(lds + NSA_UM);
    for (int i = tid; i < 64 * 257; i += 512) imp[i] = 0u;
    const bf16_t* Zm = (const bf16_t*)(p.ws + OFF_ZM);
    bf16x8 qf[4];
#pragma unroll
    for (int s = 0; s < 4; ++s) qf[s] = *(const bf16x8*)(Zm + (size_t)t * ZW + ZC_Q + hd * 64 + 16 * s + 8 * hh);
    const bf16_t* gp = Zm + (size_t)t * ZW + ZC_NG + hd;
    const float g_cmp = bf2f(gp[0]), g_slc = bf2f(gp[8]), g_win = bf2f(gp[16]);
    f32x16 ot[2];
    {
        const bf16_t* kc = (const bf16_t*)(p.ws + OFF_KC) + (size_t)g * 1024 * 64; const bf16_t* vct = (const bf16_t*)(p.ws + OFF_VCT) + (size_t)g * 64 * 1024;
        AttSt a; a.o[0] = zero16(); a.o[1] = zero16(); a.m2 = -1e30f; a.l = 0.f;
        nsa_branch<0>(lds, kc, 64, vct, 1024, qf, a, t, tq0, qt, 0.f, 0.f, qrow, tid, ql, hh);
        const float mo = __shfl_xor(a.m2, 32), lo = __shfl_xor(a.l, 32), M = fmaxf(a.m2, mo), Lt = a.l * fexp2(a.m2 - M) + lo * fexp2(mo - M);
        const float inv = (Lt > 0.f) ? 1.f / Lt : 0.f;
        nsa_branch<1>(lds, kc, 64, vct, 1024, qf, a, t, tq0, qt, M, inv, qrow, tid, ql, hh);
#pragma unroll
        for (int i = 0; i < 16; ++i) { ot[0][i] = g_cmp * a.o[0][i]; ot[1][i] = g_cmp * a.o[1][i]; }
    }
    for (int qi = 0; qi < 8; ++qi) {
        const int q = wid * 8 + qi; unsigned key[4]; bool pick[4];
#pragma unroll
        for (int i = 0; i < 4; ++i) { const int j = lane + 64 * i; key[i] = (j >= 1 && j <= qt - 1) ? imp[q * 257 + j] + 1u : 0u; }
        if (qt < 16) {
#pragma unroll
            for (int i = 0; i < 4; ++i) pick[i] = (lane + 64 * i) <= qt;
        } else {
            unsigned T = 0u;
            for (int b = 31; b >= 0; --b) { const unsigned T2 = T | (1u << b); int cnt = 0;
#pragma unroll
                for (int i = 0; i < 4; ++i) cnt += __popcll(__ballot(key[i] >= T2));
                if (cnt >= 14) T = T2; }
            int ngt = 0;
#pragma unroll
            for (int i = 0; i < 4; ++i) ngt += __popcll(__ballot(key[i] > T));
            int need = 14 - ngt, base = 0;
#pragma unroll
            for (int i = 0; i < 4; ++i) { const unsigned long long eq = __ballot(key[i] == T); const int pre = base + __popcll(eq & ((1ull << lane) - 1ull));
                const int j = lane + 64 * i; pick[i] = (key[i] > T) || (key[i] == T && pre < need) || j == 0 || j == qt; base += __popcll(eq); }
        }
#pragma unroll
        for (int i = 0; i < 4; ++i) { const unsigned long long mk = __ballot(pick[i]); if (lane == 0) { sel[q * 8 + 2 * i] = (unsigned)mk; sel[q * 8 + 2 * i + 1] = (unsigned)(mk >> 32); } }
    }
    __syncthreads();
    if (wid == 0) {
#pragma unroll
        for (int w = 0; w < 8; ++w) { unsigned x = sel[lane * 8 + w];
#pragma unroll
            for (int o = 32; o > 0; o >>= 1) x |= __shfl_xor(x, o);
            if (lane == 0) um[w] = x; }
    }
    __syncthreads();
    {
        const bf16_t* Ks = Zm + ZC_KV + 2 * 128 + g * 64; const bf16_t* Vts = (const bf16_t*)(p.ws + OFF_VT) + (size_t)(0 * 2 + g) * 64 * S;
        AttSt a; a.o[0] = zero16(); a.o[1] = zero16(); a.m2 = -1e30f; a.l = 0.f;
        nsa_branch_slc2(lds, Ks, ZW, Vts, S, qf, a, t, tq0, qt, qrow, tid, ql, hh);
        const float Lt = a.l + __shfl_xor(a.l, 32), sc = (Lt > 0.f) ? g_slc / Lt : 0.f;
#pragma unroll
        for (int i = 0; i < 16; ++i) { ot[0][i] += sc * a.o[0][i]; ot[1][i] += sc * a.o[1][i]; }
    }
    {
        const bf16_t* Kw = Zm + ZC_KV + 4 * 128 + g * 64; const bf16_t* Vtw = (const bf16_t*)(p.ws + OFF_VT) + (size_t)(1 * 2 + g) * 64 * S;
        AttSt a; a.o[0] = zero16(); a.o[1] = zero16(); a.m2 = -1e30f; a.l = 0.f;
        nsa_branch<3>(lds, Kw, ZW, Vtw, S, qf, a, t, tq0, qt, 0.f, 0.f, qrow, tid, ql, hh);
        const float Lt = a.l + __shfl_xor(a.l, 32), sc = (Lt > 0.f) ? g_win / Lt : 0.f;
#pragma unroll
        for (int i = 0; i < 16; ++i) { ot[0][i] += sc * a.o[0][i]; ot[1][i] += sc * a.o[1][i]; }
    }
    bf16_t* op = (bf16_t*)(p.ws + OFF_O4) + (size_t)t * 2048 + hd * 64 + 4 * hh;
#pragma unroll
    for (int dt = 0; dt < 2; ++dt)
#pragma unroll
        for (int gi = 0; gi < 4; ++gi) { u32x2 w; w.x = pk2(ot[dt][4 * gi], ot[dt][4 * gi + 1]); w.y = pk2(ot[dt][4 * gi + 2], ot[dt][4 * gi + 3]); *(u32x2*)(op + 32 * dt + 8 * gi) = w; }
    __syncthreads();
}


#define XB_TMO      128
#define XB_XCNT(j)  (256  + 64 * (j))
#define XB_XSUB(j)  (1280 + 64 * (j))
#define XB_XGEN(j)  (2304 + 64 * (j))
#define XB_TOP      3328
#define XB_TOPGEN   3392
#define XCD_BAR_WORDS 3456
#define XB_SPIN_CAP (1u << 18)
DI unsigned xb_ld(unsigned* p)              { return __hip_atomic_load(p, __ATOMIC_RELAXED, __HIP_MEMORY_SCOPE_AGENT); }
DI unsigned xb_add(unsigned* p, unsigned v) { return __hip_atomic_fetch_add(p, v, __ATOMIC_RELAXED, __HIP_MEMORY_SCOPE_AGENT); }
DI unsigned xb_xcc_id() { return (unsigned)__builtin_amdgcn_s_getreg((3 << 11) | 20) & 0xFu; }
#define XB_SPIN(cond, bar) do { unsigned _sp = 0; while (cond) { __builtin_amdgcn_s_sleep(1); \
    if ((++_sp & 255u) == 0u) { if (xb_ld(&(bar)[XB_TMO])) break; if (_sp > XB_SPIN_CAP) { atomicAdd(&(bar)[XB_TMO], 1u); break; } } } } while (0)
struct XcdBarrier { unsigned* bar; unsigned x; volatile LAS unsigned* st; };
DI XcdBarrier xcd_barrier_post(unsigned* bar, volatile LAS unsigned* st) {
    XcdBarrier b; b.bar = bar; b.x = xb_xcc_id(); b.st = st;
    if (threadIdx.x == 0) (void)xb_add(&bar[XB_XCNT(b.x)], 1u);
    return b;
}
DI void xcd_barrier_complete(unsigned* bar, unsigned x, unsigned& nloc, unsigned& nx) {
    const unsigned G = gridDim.x * gridDim.y * gridDim.z;
    unsigned sum, cnt, mine, sp = 0u;
    for (;;) {
        sum = 0u; cnt = 0u; mine = 0u;
#pragma unroll
        for (unsigned j = 0; j < 16; ++j) { const unsigned c = xb_ld(&bar[XB_XCNT(j)]); sum += c; cnt += (c > 0u) ? 1u : 0u; mine = (j == x) ? c : mine; }
        if (sum == G) break;
        __builtin_amdgcn_s_sleep(1);
        if ((++sp & 255u) == 0u) { if (xb_ld(&bar[XB_TMO])) break; if (sp > XB_SPIN_CAP) { atomicAdd(&bar[XB_TMO], 1u); break; } }
    }
    nloc = mine > 0u ? mine : 1u; nx = cnt > 0u ? cnt : 1u;
}
DI void xcd_barrier(const XcdBarrier& b) {
    asm volatile("s_waitcnt vmcnt(0)" ::: "memory");
    __syncthreads();
    if (threadIdx.x == 0) {
        unsigned* bar = b.bar;
        __builtin_amdgcn_s_waitcnt(0);
        unsigned nloc = b.st[0], nx = b.st[1];
        if (nloc == 0u) { xcd_barrier_complete(bar, b.x, nloc, nx); b.st[0] = nloc; b.st[1] = nx; }
        const unsigned old = xb_add(&bar[XB_XSUB(b.x)], 1u);
        const unsigned gen = old / nloc;
        if (old + 1u == (gen + 1u) * nloc) {
            __builtin_amdgcn_fence(__ATOMIC_RELEASE, "agent");
            asm volatile("s_waitcnt vmcnt(0)" ::: "memory");
            const unsigned og = xb_add(&bar[XB_TOP], 1u);
            const unsigned tg = og / nx;
            if (og + 1u == (tg + 1u) * nx) xb_add(&bar[XB_TOPGEN], 1u);
            else XB_SPIN(xb_ld(&bar[XB_TOPGEN]) == tg, bar);
            __builtin_amdgcn_fence(__ATOMIC_ACQUIRE, "agent");
            xb_add(&bar[XB_XGEN(b.x)], 1u);
            asm volatile("s_waitcnt vmcnt(0)" ::: "memory");
        } else {
            XB_SPIN(xb_ld(&bar[XB_XGEN(b.x)]) == gen, bar);
            __builtin_amdgcn_fence(__ATOMIC_ACQUIRE, "agent");
            asm volatile("s_waitcnt vmcnt(0)" ::: "memory");
        }
    }
    __syncthreads();
}
#ifndef REP_BR
#define REP_BR 1
#endif
#ifndef REP_S5
#define REP_S5 1
#endif
#ifndef REP_NSA
#define REP_NSA 1
#endif
#ifndef REP_CONV
#define REP_CONV 1
#endif
#ifndef REP_MISC
#define REP_MISC 1
#endif
#ifndef REP_GEMM
#define REP_GEMM 1
#endif
__global__ void __launch_bounds__(512) fwd_megakernel(P p) {
    extern __shared__ __attribute__((aligned(16))) unsigned char lds[];
    cg::grid_group grid = cg::this_grid();
    LAS unsigned char* l3 = (LAS unsigned char*)lds;
    const int G = gridDim.x;
    unsigned char* ws = p.ws;
    bf16_t* Xb = (bf16_t*)(ws + OFF_XB);
    bf16_t* VN = (bf16_t*)(ws + OFF_O4);
    float* SS = (float*)(ws + OFF_SS);
    volatile LAS unsigned* bst = (volatile LAS unsigned*)(l3 + LDS_BYTES - 16);
    if (threadIdx.x < 2) bst[threadIdx.x] = 0u;
    __syncthreads();
    const XcdBarrier xb = xcd_barrier_post((unsigned*)(ws + OFF_BAR), bst);
    int c = 0;
#pragma unroll 1
    for (int L = 0; L < 2; ++L) {
        c = bidx();
        for (int rep = 0; rep < REP_CONV; ++rep) conv_phase(p, L, lds);
        misc_prep(p, L);
        if (L == 0) norm_phase<false, false>(p.x, nullptr, p.g_mix, Xb, nullptr);
        if (G == 0x7fffffff) grid.sync();
        xcd_barrier(xb);
        c = bidx();
        { pg8::Gemm g{L == 0 ? Xb : VN, (const bf16_t*)(ws + OFF_WIN), DM, DM}; pg8::StaticOrder so; so.init(64, 50, G, c);
          pg8::EpiIn e{(bf16_t*)(ws + OFF_ZM), ws + OFF_G8, (const f32x2*)(ws + OFF_TRIG), L == 0 ? nullptr : SS + 2 * S}; for (int rep = 0; rep < REP_GEMM; ++rep) pg8::gemm_phase(l3, g, so, e); }
        { pg8::Gemm g{(const bf16_t*)(ws + OFF_PBF), (const bf16_t*)(ws + OFF_WPP), 256, 256}; pg8::PpOrder so{G, c};
          pg8::EpiBf<0> e{(bf16_t*)(ws + OFF_PPB), DM, nullptr}; pg8::gemm_phase(l3, g, so, e); }
        xcd_barrier(xb);
        c = bidx();
        for (int rep = 0; rep < REP_MISC; ++rep) {
        compress_phase(p, lds);
        vt_pool_phase(p);
        __syncthreads();
        for (int r5 = 0; r5 < REP_S5; ++r5) { s5_phase(p, L, lds, false); __syncthreads(); }
        __syncthreads();
        for (int it = c; it < 127 * 4; it += G) ret_pass1(p, lds, it >> 2, it & 3);
        }
        xcd_barrier(xb);
        c = bidx();
        for (int rep = 0; rep < REP_NSA; ++rep) for (int it = c; it < 512; it += G) { const int g = it >> 8, qt = g ? 255 - (it & 255) : (it & 255); nsa_item(p, lds, g, qt); }
        __syncthreads();
        for (int rep = 0; rep < REP_MISC; ++rep) {
        for (int r5 = 0; r5 < REP_S5; ++r5) { s5_phase(p, L, lds, true); __syncthreads(); }
        __syncthreads();
        for (int it = c; it < 32; it += G) ret_prefix(p, it);
        }
        xcd_barrier(xb);
        c = bidx();
        for (int rep = 0; rep < REP_MISC; ++rep) for (int it = c; it < 512; it += G) ret_pass3(p, lds, it >> 2, it & 3);
        __syncthreads();
        { pg8::Gemm g{(const bf16_t*)(ws + OFF_R2), (const bf16_t*)(ws + OFF_WGP), 512, 512}; pg8::GpOrder so{G, c};
          pg8::EpiGp e{(bf16_t*)(ws + OFF_O4) + 512, (bf16_t*)(ws + OFF_O4) + 1024, p.pool_scale + L * 512}; pg8::gemm_phase(l3, g, so, e); }
        xcd_barrier(xb);
        c = bidx();
        { pg8::Gemm g{(const bf16_t*)(ws + OFF_O4), (const bf16_t*)(ws + OFF_WBR), DM, DM}; pg8::StaticOrder so; so.init(64, 8, G, c);
          pg8::EpiBr e{ws + OFF_G8, Xb}; for (int rep = 0; rep < REP_BR; ++rep) pg8::gemm_phase(l3, g, so, e); }
        xcd_barrier(xb);
        c = bidx();
        { pg8::Gemm g{Xb, (const bf16_t*)(ws + OFF_WOUT), DM, DM}; pg8::StaticOrder so; so.init(64, 8, G, c);
          pg8::EpiH<0> e{L == 0 ? p.x : p.h, p.h, nullptr, nullptr, VN, p.g_mlp + L * DM, SS + L * S}; pg8::gemm_phase(l3, g, so, e); }
        xcd_barrier(xb);
        c = bidx();
        { pg8::Gemm g{VN, (const bf16_t*)(ws + OFF_WUP), DM, DM}; pg8::StaticOrder so; so.init(64, 32, G, c);
          pg8::EpiBf<1> e{(bf16_t*)(ws + OFF_HID), DFF, SS + L * S}; for (int rep = 0; rep < REP_GEMM; ++rep) pg8::gemm_phase(l3, g, so, e); }
        xcd_barrier(xb);
        c = bidx();
        { pg8::Gemm g{(const bf16_t*)(ws + OFF_HID), (const bf16_t*)(ws + OFF_WDN), DFF, DFF}; pg8::StaticOrder so; so.init(64, 8, G, c);
          pg8::EpiH<1> e{p.h, p.h, Xb, nullptr, nullptr, nullptr, nullptr}; pg8::gemm_phase(l3, g, so, e); }
        xcd_barrier(xb);
        c = bidx();
        { pg8::Gemm g{Xb, (const bf16_t*)(ws + OFF_WPG), DM, DM}; pg8::StaticOrder so; so.init(64, 8, G, c);
          pg8::EpiH<2> e{p.h, p.h, nullptr, (const bf16_t*)(ws + OFF_PPB), L == 0 ? VN : nullptr, p.g_mix + DM, SS + 2 * S}; pg8::gemm_phase(l3, g, so, e); }
        xcd_barrier(xb);
    }
    norm_phase<false, true>(p.h, nullptr, p.g_final, nullptr, p.h);
}

extern "C" void kernel_launch(void* const* d_in, const int* in_sizes, int n_in, void* d_out, int out_size, void* d_ws, size_t ws_size, hipStream_t stream) {
    static int grid_blocks = 0;
    if (!grid_blocks) {
        if (ws_size < WS_END) { fprintf(stderr, "kernel_launch: workspace too small: %zu < %zu\n", ws_size, (size_t)WS_END); grid_blocks = -1; return; }
        int dev = 0, cus = 0, per_cu = 0;
        hipGetDevice(&dev);
        hipDeviceGetAttribute(&cus, hipDeviceAttributeMultiprocessorCount, dev);
        hipFuncSetAttribute((const void*)fwd_megakernel, hipFuncAttributeMaxDynamicSharedMemorySize, LDS_BYTES);
        hipOccupancyMaxActiveBlocksPerMultiprocessor(&per_cu, (const void*)fwd_megakernel, 512, LDS_BYTES);
        if (per_cu < 1) per_cu = 1;
        grid_blocks = cus * per_cu;
    }
    if (grid_blocks < 0) return;
    P p{};
    const float** f = (const float**)&p;
    for (int i = 0; i < 25; ++i) f[i] = (const float*)d_in[i];
    p.h = (float*)d_out; p.ws = (unsigned char*)d_ws;
    (void)hipMemsetAsync((unsigned char*)d_ws + OFF_BAR, 0, 16384 + 3 * 65536, stream);
    void* args[] = {&p};
    hipError_t e = hipLaunchCooperativeKernel((const void*)fwd_megakernel, dim3(grid_blocks), dim3(512), args, LDS_BYTES, stream);
    if (e != hipSuccess) fprintf(stderr, "cooperative launch failed: %s (grid %d)\n", hipGetErrorString(e), grid_blocks);
}
```
